# Optimizing an MI355X kernel written in HIP

```python
import math
import jax, jax.numpy as jnp
from jax import lax
import numpy as np

D_MODEL = 2048
BATCH = 2
SEQ = 4096
DEPTH = 4

HEAD_V = 128
N_HEADS_TOTAL = D_MODEL // HEAD_V
DIFF_HEADS = N_HEADS_TOTAL // 2
GLA_HEADS = N_HEADS_TOTAL // 4
RET_HEADS = N_HEADS_TOTAL - DIFF_HEADS - GLA_HEADS
DIFF_QK = HEAD_V // 2
GLA_DK = HEAD_V // 2
GLA_DV = HEAD_V
GLA_GATE_RANK = 16
GLA_TAU = 16.0
GLA_CHUNK = 32
RET_DK = HEAD_V // 2
RET_DV = HEAD_V
RET_CHUNK = 64
ROPE_BASE = 10000.0
N_BUCKETS = 32
MAX_DISTANCE = 128
Q_BLOCK = 128
D_FF = ((8 * D_MODEL // 3 + 255) // 256) * 256
CONV_W = 3
EPS = 1e-6

DIFF_W = DIFF_HEADS * HEAD_V
GLA_W = GLA_HEADS * GLA_DV
RET_W = RET_HEADS * RET_DV
MIX_W = DIFF_W + GLA_W + RET_W
IN_SPLITS = (DIFF_HEADS * 2 * DIFF_QK, DIFF_HEADS * 2 * DIFF_QK, DIFF_W,
             GLA_HEADS * GLA_DK, GLA_HEADS * GLA_DK, GLA_W, GLA_W, GLA_GATE_RANK, GLA_GATE_RANK,
             RET_HEADS * RET_DK, RET_HEADS * RET_DK, RET_W, RET_W)
IN_W = sum(IN_SPLITS)

kernel_name = 'hybrid_parallel_head_encoder'

F32 = jnp.float32


def rmsnorm(x, g):
    xf = x.astype(F32)
    y = xf * lax.rsqrt(jnp.mean(xf * xf, axis=-1, keepdims=True) + EPS)
    return (y * g.astype(F32)).astype(x.dtype)


def split_heads(t, n):
    b, s, _ = t.shape
    return t.reshape(b, s, n, -1).transpose(0, 2, 1, 3)


def head_rmsnorm(o, g):
    of = o.astype(F32)
    of = of * lax.rsqrt(jnp.mean(of * of, axis=-1, keepdims=True) + EPS)
    b, h, t, d = o.shape
    return (of.transpose(0, 2, 1, 3).reshape(b, t, h * d) * g.astype(F32)).astype(o.dtype)


def t5_bucket(rel):
    half = N_BUCKETS // 2
    max_exact = half // 2
    ret = jnp.where(rel > 0, half, 0)
    n = jnp.abs(rel)
    nf = jnp.maximum(n, 1).astype(F32)
    large = max_exact + (jnp.log(nf / max_exact) / math.log(MAX_DISTANCE / max_exact)
                         * (half - max_exact)).astype(jnp.int32)
    large = jnp.minimum(large, half - 1)
    return ret + jnp.where(n < max_exact, n, large)


def rotary(t, positions):
    half = t.shape[-1] // 2
    inv = 1.0 / (ROPE_BASE ** jnp.linspace(0.0, 1.0, half, dtype=F32))
    ang = positions.astype(F32)[:, None] * inv[None, :]
    cos, sin = jnp.cos(ang), jnp.sin(ang)
    t1, t2 = t[..., :half].astype(F32), t[..., half:].astype(F32)
    return jnp.concatenate([t1 * cos - t2 * sin, t1 * sin + t2 * cos], axis=-1).astype(t.dtype)


def diff_attention(q, k, v, lam, bias_rel):
    b, h, t, _ = q.shape
    nb = t // Q_BLOCK
    scale = DIFF_QK ** -0.5
    k1, k2 = k[..., :DIFF_QK], k[..., DIFF_QK:]
    q_blocks = q.reshape(b, h, nb, Q_BLOCK, -1).transpose(2, 0, 1, 3, 4)
    starts = jnp.arange(nb, dtype=jnp.int32) * Q_BLOCK
    key_pos = jnp.arange(t, dtype=jnp.int32)

    def block(args):
        qb, s = args
        q_pos = s + jnp.arange(Q_BLOCK, dtype=jnp.int32)
        bias = bias_rel[:, key_pos[None, :] - q_pos[:, None] + t - 1]
        s1 = jnp.einsum('bhqd,bhkd->bhqk', qb[..., :DIFF_QK], k1).astype(F32) * scale + bias
        s2 = jnp.einsum('bhqd,bhkd->bhqk', qb[..., DIFF_QK:], k2).astype(F32) * scale + bias
        p = jax.nn.softmax(s1, axis=-1) - lam * jax.nn.softmax(s2, axis=-1)
        return jnp.einsum('bhqk,bhkd->bhqd', p.astype(v.dtype), v)

    out = lax.map(block, (q_blocks, starts))
    return out.transpose(1, 2, 0, 3, 4).reshape(b, h, t, -1)


def chunk_states(k_end, v, chunk_decay):
    kv = jnp.einsum('bhnck,bhncv->nbhkv', k_end, v)
    dec = jnp.moveaxis(chunk_decay, 2, 0)[..., None]

    def step(state, inp):
        kv_n, d_n = inp
        return d_n * state + kv_n, state

    init = jnp.zeros(kv.shape[1:], kv.dtype)
    _, prev = lax.scan(step, init, (kv, dec))
    return jnp.moveaxis(prev, 0, 2)


def gla_direction(q, k, v, log_a):
    b, h, t, dk = q.shape
    dv = v.shape[-1]
    c = GLA_CHUNK
    n = t // c
    q, k = q.reshape(b, h, n, c, dk), k.reshape(b, h, n, c, dk)
    v = v.reshape(b, h, n, c, dv)
    cum = jnp.cumsum(log_a.astype(F32).reshape(b, h, n, c, dk), axis=3)
    last = cum[..., -1:, :]
    lower = jnp.tril(jnp.ones((c, c), dtype=bool))
    pair = jnp.where(lower[:, :, None],
                     jnp.exp(jnp.minimum(cum[..., :, None, :] - cum[..., None, :, :], 0.0)), 0.0)
    scores = jnp.einsum('bhnik,bhnjk,bhnijk->bhnij', q, k, pair.astype(q.dtype))
    intra = jnp.einsum('bhnij,bhnjv->bhniv', scores, v)
    states = chunk_states(k * jnp.exp(last - cum).astype(k.dtype), v,
                          jnp.exp(last[..., 0, :]).astype(k.dtype))
    inter = jnp.einsum('bhnik,bhnkv->bhniv', q * jnp.exp(cum).astype(q.dtype), states)
    return (intra + inter).reshape(b, h, t, dv)


def retention_direction(q, k, v, log_gamma):
    b, h, t, dk = q.shape
    dv = v.shape[-1]
    c = RET_CHUNK
    n = t // c
    q, k = q.reshape(b, h, n, c, dk), k.reshape(b, h, n, c, dk)
    v = v.reshape(b, h, n, c, dv)
    pos = jnp.arange(c, dtype=F32)
    rel = pos[:, None] - pos[None, :]
    lg = log_gamma.astype(F32)
    decay = jnp.where(rel >= 0, jnp.exp(lg[:, None, None] * jnp.maximum(rel, 0.0)), 0.0)
    scores = jnp.einsum('bhnid,bhnjd->bhnij', q, k) * decay[None, :, None].astype(q.dtype)
    intra = jnp.einsum('bhnij,bhnjv->bhniv', scores, v)
    xi = jnp.exp(lg[:, None] * (pos + 1.0))
    zeta = jnp.exp(lg[:, None] * (c - 1.0 - pos))
    chunk_dec = jnp.broadcast_to(jnp.exp(lg * c)[None, :, None, None], (b, h, n, dk))
    states = chunk_states(k * zeta[None, :, None, :, None].astype(k.dtype), v, chunk_dec.astype(k.dtype))
    inter = jnp.einsum('bhnid,bhndv->bhniv', q, states) * xi[None, :, None, :, None].astype(q.dtype)
    return (intra + inter).reshape(b, h, t, dv)


def flip_t(z):
    return jnp.flip(z, axis=2)


def hybrid_mixer(h, w_in, lam_params, lam_init, bias_rel, gate_w, gate_b,
                 decay_logit, head_gain, w_o):
    t = h.shape[1]
    proj = h @ w_in
    split_idx = [int(i) for i in np.cumsum(IN_SPLITS)[:-1]]
    (dq, dk, dv, gq, gk, gv, gr, ga_f, ga_b, rq, rk, rv, rg) = jnp.split(proj, split_idx, axis=-1)
    g_diff = head_gain[:DIFF_W]
    g_gla = head_gain[DIFF_W:DIFF_W + GLA_W]
    g_ret = head_gain[DIFF_W + GLA_W:]

    lp = lam_params.astype(F32)
    lam = jnp.exp(jnp.sum(lp[0] * lp[1])) - jnp.exp(jnp.sum(lp[2] * lp[3])) + lam_init
    a_out = diff_attention(split_heads(dq, DIFF_HEADS), split_heads(dk, DIFF_HEADS),
                           split_heads(dv, DIFF_HEADS), lam, bias_rel)
    a_out = head_rmsnorm(a_out, g_diff) * (1.0 - lam_init)

    q = split_heads(gq, GLA_HEADS) * (GLA_DK ** -0.5)
    k = split_heads(gk, GLA_HEADS)
    v = split_heads(gv, GLA_HEADS)
    la_f = split_heads(jax.nn.log_sigmoid((ga_f @ gate_w[0] + gate_b[0]).astype(F32)) / GLA_TAU, GLA_HEADS)
    la_b = split_heads(jax.nn.log_sigmoid((ga_b @ gate_w[1] + gate_b[1]).astype(F32)) / GLA_TAU, GLA_HEADS)
    o = gla_direction(q, k, v, la_f) + flip_t(gla_direction(flip_t(q), flip_t(k), flip_t(v), flip_t(la_b)))
    b_out = head_rmsnorm(o, g_gla) * jax.nn.silu(gr)

    pos = jnp.arange(t, dtype=jnp.int32)
    q = rotary(split_heads(rq, RET_HEADS), pos)
    k = rotary(split_heads(rk, RET_HEADS), pos) * (RET_DK ** -0.5)
    v = split_heads(rv, RET_HEADS)
    log_gamma = jax.nn.log_sigmoid(decay_logit.astype(F32))
    o = retention_direction(q, k, v, log_gamma[0]) + flip_t(
        retention_direction(flip_t(q), flip_t(k), flip_t(v), log_gamma[1]))
    c_out = head_rmsnorm(o, g_ret) * jax.nn.silu(rg)

    merged = jnp.concatenate([a_out, b_out, c_out], axis=-1).astype(h.dtype)
    return merged @ w_o


def conv_ffn(h, w_up, conv_w, conv_b, w_down):
    t = h.shape[1]
    u = h @ w_up
    pad = CONV_W // 2
    up = jnp.pad(u, ((0, 0), (pad, pad), (0, 0)))
    u = sum(up[:, i:i + t] * conv_w[i] for i in range(CONV_W)) + conv_b
    a, g = jnp.split(u, 2, axis=-1)
    return (a * jax.nn.silu(g)) @ w_down


def setup_inputs(seed: int = 0) -> dict:
    key = jax.random.key(seed)
    ks = jax.random.split(key, 16)
    nrm = jax.random.normal
    base_logit = jnp.log(2.0 ** (5.0 + jnp.arange(RET_HEADS, dtype=F32)) - 1.0)
    return {
        'x': nrm(ks[0], (BATCH, SEQ, D_MODEL), F32),
        'ln1_g': 1.0 + 0.02 * nrm(ks[1], (DEPTH, D_MODEL), F32),
        'w_in': nrm(ks[2], (DEPTH, D_MODEL, IN_W), F32) * D_MODEL ** -0.5,
        'diff_lambda': 0.1 * nrm(ks[3], (DEPTH, 4, DIFF_QK), F32),
        'rel_bias': 0.5 * nrm(ks[4], (N_BUCKETS, DIFF_HEADS), F32),
        'gla_gate_w': nrm(ks[5], (DEPTH, 2, GLA_GATE_RANK, GLA_HEADS * GLA_DK), F32) * GLA_GATE_RANK ** -0.5,
        'gla_gate_b': 0.1 * nrm(ks[6], (DEPTH, 2, GLA_HEADS * GLA_DK), F32),
        'ret_decay_logit': base_logit + 0.05 * nrm(ks[7], (DEPTH, 2, RET_HEADS), F32),
        'head_gain': 1.0 + 0.02 * nrm(ks[8], (DEPTH, MIX_W), F32),
        'w_o': nrm(ks[9], (DEPTH, MIX_W, D_MODEL), F32) * MIX_W ** -0.5,
        'ln2_g': 1.0 + 0.02 * nrm(ks[10], (DEPTH, D_MODEL), F32),
        'w_up': nrm(ks[11], (DEPTH, D_MODEL, 2 * D_FF), F32) * D_MODEL ** -0.5,
        'conv_w': nrm(ks[12], (DEPTH, CONV_W, 2 * D_FF), F32) * CONV_W ** -0.5,
        'conv_b': 0.02 * nrm(ks[13], (DEPTH, 2 * D_FF), F32),
        'w_down': nrm(ks[14], (DEPTH, D_FF, D_MODEL), F32) * D_FF ** -0.5,
        'final_g': 1.0 + 0.02 * nrm(ks[15], (D_MODEL,), F32),
    }


def reference(x, ln1_g, w_in, diff_lambda, rel_bias, gla_gate_w, gla_gate_b, ret_decay_logit,
              head_gain, w_o, ln2_g, w_up, conv_w, conv_b, w_down, final_g):
    t = x.shape[1]
    rel = jnp.arange(-(t - 1), t, dtype=jnp.int32)
    bias_rel = rel_bias.astype(F32)[t5_bucket(rel)].T
    for layer in range(DEPTH):
        lam_init = 0.8 - 0.6 * math.exp(-0.3 * layer)
        h = rmsnorm(x, ln1_g[layer])
        x = x + hybrid_mixer(h, w_in[layer], diff_lambda[layer], lam_init, bias_rel,
                             gla_gate_w[layer], gla_gate_b[layer], ret_decay_logit[layer],
                             head_gain[layer], w_o[layer])
        h = rmsnorm(x, ln2_g[layer])
        x = x + conv_ffn(h, w_up[layer], conv_w[layer], conv_b[layer], w_down[layer])
    return rmsnorm(x, final_g)
```

```cpp
#include <hip/hip_runtime.h>
#include <hip/hip_cooperative_groups.h>
#include <cstdio>
#include <cstdint>
namespace cg = cooperative_groups;

#ifndef MK_MULTI
#define MK_MULTI 0
#endif

#ifndef PROBE_SUB
#define PROBE_SUB -1
#endif
#define LAS __attribute__((address_space(3)))
typedef unsigned short bf16_t;
typedef short bf16x8 __attribute__((ext_vector_type(8)));
typedef short s16x4 __attribute__((ext_vector_type(4)));
typedef float f32x2 __attribute__((ext_vector_type(2)));
typedef float f32x4 __attribute__((ext_vector_type(4)));
typedef float f32x16 __attribute__((ext_vector_type(16)));
typedef unsigned u32x2 __attribute__((ext_vector_type(2)));
typedef unsigned u32x4 __attribute__((ext_vector_type(4)));

constexpr int NB = 2, T = 4096, M = NB * T, D = 2048, INW = 6176, INP = 6400, DFF = 5632, UPW = 2 * DFF, DEPTH = 4;
constexpr int OQ = 0, OKK = 1024, OV = 2048, GQ = 3072, GK = 3328, GV = 3584, GR = 4096, RQ = 4608, RK = 4864, RV = 5120, RG = 5632, GAF = 6144, GAB = 6160, NGEMM_IN = 6144;
constexpr int SRC_GA = 4608, SRC_RK = 4896, SRC_RV = 5152;
constexpr float EPS = 1e-6f;
constexpr int NTHR = 512, NWAVE = 8;
constexpr int BTAB_N = 448, BTAB_OFF = 224;

constexpr size_t MiB = 1u << 20;
constexpr size_t WS_SS = 0;
constexpr size_t SS_BYTES = 1 * MiB;
constexpr size_t WS_BAR = 768 * 1024;
constexpr size_t WS_LAM = 1 * MiB;
constexpr size_t WS_BTAB = 1 * MiB + 4096;
constexpr size_t WS_ROPE = 2 * MiB;
constexpr size_t WS_W = 3 * MiB;
constexpr size_t W_IN = 0, W_O = 25 * MiB, W_UP = 33 * MiB, W_DN = 77 * MiB, W_LAYER = 99 * MiB;
constexpr size_t WS_XB = WS_W + 4 * W_LAYER;
constexpr size_t WS_PROJ = WS_XB + 32 * MiB;
constexpr size_t WS_MRG = WS_PROJ + 100 * MiB;
constexpr size_t WS_U = WS_MRG + 32 * MiB;
constexpr size_t WS_ACT = WS_U + 176 * MiB;
constexpr size_t WS_KVT = WS_ACT + 88 * MiB;
constexpr size_t WS_ST = WS_KVT + 64 * MiB;
constexpr size_t WS_DEC = WS_ST + 32 * MiB;
constexpr size_t WS_O1 = WS_DEC + 1 * MiB;
constexpr size_t WS_END = WS_O1 + 32 * MiB;

constexpr int LDS_BYTES = 131072 + 256 + 11 * 1024 + 512 * 16 + 4096;

__device__ __forceinline__ unsigned cvt_pk_bf16(float lo, float hi) { unsigned r; asm volatile("v_cvt_pk_bf16_f32 %0, %1, %2" : "=v"(r) : "v"(lo), "v"(hi)); return r; }
__device__ __forceinline__ unsigned f2bf(float f) { unsigned u = __builtin_bit_cast(unsigned, f); return (u + 0x7fffu + ((u >> 16) & 1u)) >> 16; }
__device__ __forceinline__ float bf2f(unsigned short h) { return __builtin_bit_cast(float, (unsigned)h << 16); }
__device__ __forceinline__ float bflo(unsigned w) { return __builtin_bit_cast(float, w << 16); }
__device__ __forceinline__ float bfhi(unsigned w) { return __builtin_bit_cast(float, w & 0xffff0000u); }
__device__ __forceinline__ float logsigmoidf(float x) { return fminf(x, 0.f) - __logf(1.f + __expf(-fabsf(x))); }
__device__ __forceinline__ float siluf(float x) { return x * __builtin_amdgcn_rcpf(1.f + __expf(-x)); }
__device__ __forceinline__ float wave_sum(float v) {
#pragma unroll
    for (int o = 1; o < 64; o <<= 1) v += __shfl_xor(v, o);
    return v;
}
#define LDS_WAIT() asm volatile("s_waitcnt lgkmcnt(0)" ::: "memory")
typedef unsigned long long u64_t;
constexpr float SS_FX = 16777216.0f, SS_IFX = 1.0f / 16777216.0f;
__device__ __forceinline__ float ss_rstd(const u64_t* ss, int row) { return __builtin_amdgcn_rsqf((float)ss[row] * (SS_IFX / (float)2048) + 1e-6f); }
__device__ __forceinline__ int otid() { int t = threadIdx.x; asm volatile("" : "+v"(t)); return t; }

namespace pg8 {
constexpr int BM = 256, BK = 64, HALF = 128, HTB = HALF * BK * 2, STAGE_BYTES = 8 * HTB, NXCD = 8, WGM = 4;
__host__ __device__ __forceinline__ int lds_byte(int r, int c) { const int st = (r >> 4) * 2 + (c >> 5), rr = r & 15, cc = c & 31, ob = rr * 64 + cc * 2; return st * 1024 + (ob ^ (((ob >> 9) & 1) << 5)); }
__host__ __device__ __forceinline__ void stage_rc(int b, int& R, int& C) { const int st = b / 1024, sb = b % 1024, swz = sb ^ (((sb >> 9) & 1) << 5); R = (st >> 1) * 16 + swz / 64; C = (st & 1) * 32 + (swz % 64) / 2; }
__host__ __device__ __forceinline__ int perm32(int rho) { const int n = rho >> 4, i = rho & 15; return 8 * (i >> 2) + 4 * n + (i & 3); }
struct Unit { int pm, pn; };
struct Gemm { const bf16_t* A; const bf16_t* Bt; int M, N, K; };
struct StaticOrder {
    int nM, nN, nwg, G, c;
    __host__ __device__ void init(int M_, int N_, int G_, int c_) { nM = M_ / BM; nN = N_ / BM; nwg = nM * nN; G = G_; c = c_; }
    __host__ __device__ bool next(int i, Unit& u) const {
        const long L = (long)i * G + c; if (L >= nwg) return false;
        int wgid = (int)L; { const int q = nwg / NXCD, r = nwg % NXCD, xcd = wgid % NXCD, off = wgid / NXCD; wgid = (xcd < r ? xcd * (q + 1) : r * (q + 1) + (xcd - r) * q) + off; }
        const int nig = WGM * nN, gid = wgid / nig, fm = gid * WGM, gsz = (nM - fm) < WGM ? (nM - fm) : WGM;
        u.pm = fm + ((wgid % nig) % gsz); u.pn = (wgid % nig) / gsz; return true;
    }
    __device__ __forceinline__ void a_ready(const Unit&) const {}
    __device__ __forceinline__ void done(const Unit&) const {}
};

struct EpiScaleBf16 {
    static constexpr bool PERM = true, AFTER_DRAIN = false;
    bf16_t* O; int ldc; const u64_t* ss;
    __device__ __forceinline__ void operator()(const f32x4 (&acc)[2][2][4][2], const Unit& u, int wr, int wc, int fr, int fq) const {
        const int row0 = u.pm * BM + wr * 64 + fr, col0 = u.pn * BM + wc * 32 + 8 * fq;
#pragma unroll
        for (int ai = 0; ai < 2; ++ai)
#pragma unroll
            for (int m = 0; m < 4; ++m) {
                const int row = row0 + ai * HALF + m * 16;
                const float sc = ss_rstd(ss, row);
                bf16_t* rowp = O + (size_t)row * ldc + col0;
#pragma unroll
                for (int bj = 0; bj < 2; ++bj) { const f32x4 v0 = acc[ai][bj][m][0] * sc, v1 = acc[ai][bj][m][1] * sc;
                    u32x4 w; w.x = cvt_pk_bf16(v0[0], v0[1]); w.y = cvt_pk_bf16(v0[2], v0[3]); w.z = cvt_pk_bf16(v1[0], v1[1]); w.w = cvt_pk_bf16(v1[2], v1[3]);
                    *(u32x4*)(rowp + bj * HALF) = w; }
                asm volatile("" ::: "memory");
            }
    }
};

#define DPPF(old, src, ctrl) __builtin_bit_cast(float, __builtin_amdgcn_update_dpp(__builtin_bit_cast(int, (float)(old)), __builtin_bit_cast(int, (float)(src)), (ctrl), 0xf, 0xf, false))
__device__ __forceinline__ f32x4 dpp4_shr1(f32x4 o, f32x4 v) { return (f32x4){DPPF(o[0], v[0], 0x111), DPPF(o[1], v[1], 0x111), DPPF(o[2], v[2], 0x111), DPPF(o[3], v[3], 0x111)}; }
__device__ __forceinline__ f32x4 dpp4_shl1(f32x4 o, f32x4 v) { return (f32x4){DPPF(o[0], v[0], 0x101), DPPF(o[1], v[1], 0x101), DPPF(o[2], v[2], 0x101), DPPF(o[3], v[3], 0x101)}; }
__device__ __forceinline__ f32x4 dpp4_ror1(f32x4 v) { return (f32x4){DPPF(v[0], v[0], 0x121), DPPF(v[1], v[1], 0x121), DPPF(v[2], v[2], 0x121), DPPF(v[3], v[3], 0x121)}; }
__device__ __forceinline__ f32x4 dpp4_ror15(f32x4 v) { return (f32x4){DPPF(v[0], v[0], 0x12f), DPPF(v[1], v[1], 0x12f), DPPF(v[2], v[2], 0x12f), DPPF(v[3], v[3], 0x12f)}; }
struct EpiConvGate {
    static constexpr bool PERM = true, AFTER_DRAIN = false;
    bf16_t* ACT; const u64_t* ss; const float* cw; const float* cb; float* HB; LAS float* HL;
    __device__ __forceinline__ void operator()(f32x4 (&acc)[2][2][4][2], const Unit& u, int wr, int wc, int fr_in, int fq_in) const {
        int fr = fr_in, fq = fq_in; asm volatile("" : "+v"(fr), "+v"(fq));
        const int wv = wr * 4 + wc;
        LAS float* PAL = HL + 9 * 256; LAS float* DMP = HL + 11 * 256 + (wv * 64 + fq * 16 + fr) * 4; LAS float* WL = HL + 11 * 256 + 512 * 4;
        if (wv < 4) { const int cl = wv * 64 + fq * 16 + fr, ch = ((cl >> 7) ? DFF : 0) + u.pn * 128 + (cl & 127);
            WL[cl] = cw[ch]; WL[256 + cl] = cw[UPW + ch]; WL[512 + cl] = cw[2 * UPW + ch]; WL[768 + cl] = cb[ch]; }
#pragma unroll
        for (int ai = 0; ai < 2; ++ai)
#pragma unroll
            for (int m = 0; m < 4; ++m) { asm volatile("" : "+v"(fr)); const float sc = ss_rstd(ss, u.pm * BM + ai * HALF + wr * 64 + m * 16 + fr);
#pragma unroll
                for (int bj = 0; bj < 2; ++bj)
#pragma unroll
                    for (int n = 0; n < 2; ++n) acc[ai][bj][m][n] *= sc; }
        float* hb = HB + (size_t)(u.pm * (UPW / 256) + u.pn) * 1024;
#pragma unroll
        for (int ai = 0; ai < 2; ++ai) { const int blk = 2 * ai + wr;
            asm volatile("" : "+v"(fr), "+v"(fq)); const int lc0 = wc * 32 + 8 * fq;
#pragma unroll
            for (int bj = 0; bj < 2; ++bj)
#pragma unroll
                for (int n = 0; n < 2; ++n) {
                    LAS float* d0 = fr == 0 ? HL + (blk * 2 + 0) * 256 + bj * 128 + lc0 + 4 * n : DMP;
                    LAS float* d1 = fr == 15 ? HL + (blk * 2 + 1) * 256 + bj * 128 + lc0 + 4 * n : DMP;
                    *(LAS f32x4*)d0 = acc[ai][bj][0][n]; *(LAS f32x4*)d1 = acc[ai][bj][3][n]; }
        }
        asm volatile("s_waitcnt lgkmcnt(0)" ::: "memory"); __builtin_amdgcn_s_barrier(); asm volatile("" ::: "memory");
        if (wv == 0) { const int l4 = (fq * 16 + fr) * 4;
            *(f32x4*)(hb + l4) = *(const LAS f32x4*)(HL + l4); *(f32x4*)(hb + 256 + l4) = *(const LAS f32x4*)(HL + 7 * 256 + l4); }
#pragma unroll
        for (int ai = 0; ai < 2; ++ai) { const int blk = 2 * ai + wr;
            const int upslot = blk > 0 ? (blk - 1) * 2 + 1 : 8, dnslot = blk < 3 ? (blk + 1) * 2 : 8;
#pragma unroll
            for (int q = 0; q < 4; ++q) { const int bj = q >> 1, n = q & 1;
                asm volatile("" : "+v"(fr), "+v"(fq)); const int lc0 = wc * 32 + 8 * fq;
                const int cl = bj * 128 + lc0 + 4 * n;
                const f32x4 w0 = *(const LAS f32x4*)(WL + cl), w1 = *(const LAS f32x4*)(WL + 256 + cl), w2 = *(const LAS f32x4*)(WL + 512 + cl), bb = *(const LAS f32x4*)(WL + 768 + cl);
                f32x4 carry = *(const LAS f32x4*)(HL + upslot * 256 + bj * 128 + lc0 + 4 * n);
                const f32x4 hdn = *(const LAS f32x4*)(HL + dnslot * 256 + bj * 128 + lc0 + 4 * n);
#pragma unroll
                for (int m = 0; m < 4; ++m) { const f32x4 cur = acc[ai][bj][m][n];
                    const f32x4 up = dpp4_shr1(carry, cur);
                    const f32x4 nf = m < 3 ? dpp4_ror15(acc[ai][bj][m < 3 ? m + 1 : 3][n]) : hdn;
                    const f32x4 dn = dpp4_shl1(nf, cur);
                    carry = dpp4_ror1(cur);
                    acc[ai][bj][m][n] = w0 * up + w1 * cur + w2 * dn + bb; }
                if (ai == 0) { LAS float* d0 = ((wr == 0) & (fr == 0)) ? PAL + bj * 128 + lc0 + 4 * n : DMP; *(LAS f32x4*)d0 = acc[ai][bj][0][n]; }
                if (ai == 1) { LAS float* d1 = ((wr == 1) & (fr == 15)) ? PAL + 256 + bj * 128 + lc0 + 4 * n : DMP; *(LAS f32x4*)d1 = acc[ai][bj][3][n]; }
                asm volatile("s_waitcnt lgkmcnt(0)" ::: "memory");
            }
            asm volatile("" : "+v"(fr), "+v"(fq));
#pragma unroll
            for (int m = 0; m < 4; ++m) { const int row = u.pm * BM + ai * HALF + wr * 64 + m * 16 + fr;
                const f32x4 a0 = acc[ai][0][m][0], a1 = acc[ai][0][m][1], g0 = acc[ai][1][m][0], g1 = acc[ai][1][m][1];
                u32x4 w; w.x = cvt_pk_bf16(a0[0] * siluf(g0[0]), a0[1] * siluf(g0[1])); w.y = cvt_pk_bf16(a0[2] * siluf(g0[2]), a0[3] * siluf(g0[3]));
                w.z = cvt_pk_bf16(a1[0] * siluf(g1[0]), a1[1] * siluf(g1[1])); w.w = cvt_pk_bf16(a1[2] * siluf(g1[2]), a1[3] * siluf(g1[3]));
                *(u32x4*)(ACT + (size_t)row * DFF + u.pn * 128 + wc * 32 + 8 * fq) = w;
                asm volatile("" ::: "memory"); }
        }
        asm volatile("s_waitcnt lgkmcnt(0)" ::: "memory"); __builtin_amdgcn_s_barrier(); asm volatile("" ::: "memory");
        if (wv == 0) { const int l4 = (fq * 16 + fr) * 4;
            *(f32x4*)(hb + 512 + l4) = *(const LAS f32x4*)(PAL + l4); *(f32x4*)(hb + 768 + l4) = *(const LAS f32x4*)(PAL + 256 + l4);
            asm volatile("s_waitcnt lgkmcnt(0)" ::: "memory"); }
    }
};
struct EpiResid {
    static constexpr bool PERM = false, AFTER_DRAIN = false;
    float* X; bf16_t* XB; u64_t* ssn;
    __device__ __forceinline__ void operator()(const f32x4 (&acc)[2][2][4][2], const Unit& u, int wr, int wc, int fr, int fq) const {
        const int col0 = u.pn * BM + wc * 32 + 4 * fq;
#pragma unroll
        for (int ai = 0; ai < 2; ++ai)
#pragma unroll
            for (int m = 0; m < 4; ++m) {
                const int row = u.pm * BM + ai * HALF + wr * 64 + m * 16 + fr; const size_t off = (size_t)row * D + col0; float part = 0.f;
#pragma unroll
                for (int bj = 0; bj < 2; ++bj)
#pragma unroll
                    for (int n = 0; n < 2; ++n) { float* xp = X + off + bj * HALF + n * 16; const f32x4 xv = *(const f32x4*)xp + acc[ai][bj][m][n]; *(f32x4*)xp = xv;
                        part += (xv[0] * xv[0] + xv[1] * xv[1]) + (xv[2] * xv[2] + xv[3] * xv[3]);
                        u32x2 w; w.x = cvt_pk_bf16(xv[0], xv[1]); w.y = cvt_pk_bf16(xv[2], xv[3]); *(u32x2*)(XB + off + bj * HALF + n * 16) = w; }
                part += __shfl_xor(part, 16); part += __shfl_xor(part, 32);
                if (fq == 0) atomicAdd(ssn + row, (u64_t)(part * SS_FX + 0.5f));
                asm volatile("" ::: "memory");
            }
    }
};

template <class Epi, class Sched, bool ALIGN_EPI = false, bool SP2 = false>
__device__ __forceinline__ void gemm_phase(LAS unsigned char* lds, const Gemm g, const Sched& S, const Epi& E) {
    const int tid = otid(), wid = __builtin_amdgcn_readfirstlane(tid >> 6), lane = tid & 63, wr = wid >> 2, wc = wid & 3, fr = lane & 15, fq = lane >> 4;
    const int K = g.K, nt = K / BK;
    unsigned voffA[2], voffB[2];
#pragma unroll
    for (int i = 0; i < 2; ++i) { int R, C; stage_rc(tid * 16 + i * 8192, R, C); const int Rb = Epi::PERM ? ((R & ~31) + perm32(R & 31)) : R;
        voffA[i] = (unsigned)(R * K + C) * 2u; voffB[i] = (unsigned)(Rb * K + C) * 2u; }
    const size_t kstep = (size_t)(BK * 2);
    const size_t hstep = (size_t)HALF * K * 2;
    const size_t tstep = 2 * hstep;
    const unsigned ldsw = (unsigned)wid * 1024u;
    const int aoff = lds_byte(wr * 64 + fr, fq * 8), boff = lds_byte(wc * 32 + fr, fq * 8);
#define PG8_SA(b, h) (((b) * 2 + (h)) * HTB)
#define PG8_SB(b, h) ((4 + (b) * 2 + (h)) * HTB)
#define PG8_STAGE(bufoff, gbase, voff) do { _Pragma("unroll") for (int _i = 0; _i < 2; ++_i) \
        __builtin_amdgcn_global_load_lds((const unsigned*)((const char*)(gbase) + (voff)[_i]), (LAS unsigned*)(lds + (bufoff) + ldsw + _i * 8192), 16, 0, 0); } while (0)
#define PG8_LDA(dst, b, h) do { _Pragma("unroll") for (int m = 0; m < 4; ++m) _Pragma("unroll") for (int k = 0; k < 2; ++k) dst[m][k] = *(const LAS bf16x8*)(lds + PG8_SA(b, h) + aoff + m * 2048 + k * 1024); } while (0)
#define PG8_LDB(dst, b, h) do { _Pragma("unroll") for (int n = 0; n < 2; ++n) _Pragma("unroll") for (int k = 0; k < 2; ++k) dst[n][k] = *(const LAS bf16x8*)(lds + PG8_SB(b, h) + boff + n * 2048 + k * 1024); } while (0)
#define PG8_MMA(ai, bj, At, Bt) do { __builtin_amdgcn_s_setprio(1); _Pragma("unroll") for (int m = 0; m < 4; ++m) _Pragma("unroll") for (int n = 0; n < 2; ++n) _Pragma("unroll") for (int k = 0; k < 2; ++k) \
        acc[ai][bj][m][n] = __builtin_amdgcn_mfma_f32_16x16x32_bf16(Bt[n][k], At[m][k], acc[ai][bj][m][n], 0, 0, 0); __builtin_amdgcn_s_setprio(0); } while (0)
#define PG8_WAIT_V(n) asm volatile("s_waitcnt vmcnt(" #n ")" ::: "memory")
#define PG8_WAIT_L(n) asm volatile("s_waitcnt lgkmcnt(" #n ")" ::: "memory")
#define PG8_BAR __builtin_amdgcn_s_barrier()
#define PG8_SCHED __builtin_amdgcn_sched_barrier(0)
    Unit cur, nxt; int ui = 0;
    if (!S.next(0, cur)) return;
    f32x4 acc[2][2][4][2];
#pragma unroll
    for (int a = 0; a < 2; ++a)
#pragma unroll
        for (int b = 0; b < 2; ++b)
#pragma unroll
            for (int m = 0; m < 4; ++m)
#pragma unroll
                for (int n = 0; n < 2; ++n) acc[a][b][m][n] = (f32x4){0.f, 0.f, 0.f, 0.f};
    bf16x8 At[4][2], B0[2][2], B1[2][2];
    const char* cA = (const char*)g.A + (size_t)cur.pm * tstep; const char* cB = (const char*)g.Bt + (size_t)cur.pn * tstep;
    S.a_ready(cur);
    if constexpr (SP2) {
        PG8_STAGE(PG8_SB(0, 0), cB, voffB); PG8_STAGE(PG8_SB(0, 1), cB + hstep, voffB); PG8_STAGE(PG8_SA(0, 0), cA, voffA); PG8_STAGE(PG8_SA(0, 1), cA + hstep, voffA);
        if (wr == 1) PG8_BAR;
        PG8_WAIT_V(2); PG8_BAR;
        PG8_STAGE(PG8_SB(1, 0), cB + kstep, voffB); PG8_STAGE(PG8_SA(1, 0), cA + kstep, voffA); PG8_STAGE(PG8_SB(1, 1), cB + hstep + kstep, voffB);
        PG8_WAIT_V(6); PG8_BAR;
    } else {
        PG8_STAGE(PG8_SB(0, 0), cB, voffB); PG8_STAGE(PG8_SA(0, 0), cA, voffA); PG8_STAGE(PG8_SB(0, 1), cB + hstep, voffB); PG8_STAGE(PG8_SA(0, 1), cA + hstep, voffA);
        if (wr == 1) PG8_BAR;
        PG8_WAIT_V(4); PG8_BAR;
        PG8_STAGE(PG8_SB(1, 0), cB + kstep, voffB); PG8_STAGE(PG8_SA(1, 0), cA + kstep, voffA); PG8_STAGE(PG8_SB(1, 1), cB + hstep + kstep, voffB);
        PG8_WAIT_V(6); PG8_BAR;
    }
    for (;;) {
        const bool has_next = S.next(ui + 1, nxt);
        const char* nA = has_next ? (const char*)g.A + (size_t)nxt.pm * tstep : cA; const char* nB = has_next ? (const char*)g.Bt + (size_t)nxt.pn * tstep : cB;
        for (int t = 0; t < nt; t += 2) {
            const bool last = (t == nt - 2);
            const char* a1 = cA + (size_t)(t + 1) * kstep;
            const char* a2 = last ? nA : cA + (size_t)(t + 2) * kstep; const char* b2 = last ? nB : cB + (size_t)(t + 2) * kstep;
            const char* a3 = a2 + kstep; const char* b3 = b2 + kstep;
            if (last && has_next) S.a_ready(nxt);
            if constexpr (SP2) {
            PG8_LDB(B0, 0, 0); PG8_LDB(B1, 0, 1); PG8_SCHED; PG8_LDA(At, 0, 0); PG8_STAGE(PG8_SA(1, 1), a1 + hstep, voffA);
            PG8_WAIT_V(8); PG8_WAIT_L(0); PG8_BAR; PG8_MMA(0, 0, At, B0); PG8_MMA(0, 1, At, B1); PG8_BAR; PG8_SCHED;
            PG8_LDA(At, 0, 1); PG8_STAGE(PG8_SB(0, 0), b2, voffB); PG8_STAGE(PG8_SB(0, 1), b2 + hstep, voffB); PG8_STAGE(PG8_SA(0, 0), a2, voffA);
            PG8_WAIT_V(8); PG8_WAIT_L(0); PG8_BAR; PG8_MMA(1, 0, At, B0); PG8_MMA(1, 1, At, B1); PG8_BAR; PG8_SCHED;
            PG8_LDB(B0, 1, 0); PG8_LDB(B1, 1, 1); PG8_SCHED; PG8_LDA(At, 1, 0); PG8_STAGE(PG8_SA(0, 1), a2 + hstep, voffA);
            PG8_WAIT_V(8); PG8_WAIT_L(0); PG8_BAR; PG8_MMA(0, 0, At, B0); PG8_MMA(0, 1, At, B1); PG8_BAR; PG8_SCHED;
            PG8_LDA(At, 1, 1); PG8_STAGE(PG8_SB(1, 0), b3, voffB); PG8_STAGE(PG8_SB(1, 1), b3 + hstep, voffB); PG8_STAGE(PG8_SA(1, 0), a3, voffA);
            PG8_WAIT_V(8); PG8_WAIT_L(0); PG8_BAR; PG8_MMA(1, 0, At, B0); PG8_MMA(1, 1, At, B1); PG8_BAR; PG8_SCHED;
            } else {
            PG8_LDB(B0, 0, 0); PG8_SCHED; PG8_LDA(At, 0, 0); PG8_STAGE(PG8_SA(1, 1), a1 + hstep, voffA);
            PG8_WAIT_L(8); PG8_BAR; PG8_WAIT_L(0); PG8_MMA(0, 0, At, B0); PG8_BAR; PG8_SCHED;
            PG8_LDB(B1, 0, 1); PG8_STAGE(PG8_SB(0, 0), b2, voffB);
            PG8_BAR; PG8_WAIT_L(0); PG8_MMA(0, 1, At, B1); PG8_BAR;
            PG8_LDA(At, 0, 1); PG8_STAGE(PG8_SA(0, 0), a2, voffA);
            PG8_BAR; PG8_WAIT_L(0); PG8_MMA(1, 0, At, B0); PG8_BAR; PG8_SCHED;
            PG8_STAGE(PG8_SB(0, 1), b2 + hstep, voffB);
            PG8_WAIT_V(6); PG8_BAR; PG8_MMA(1, 1, At, B1); PG8_BAR;
            PG8_LDB(B0, 1, 0); PG8_SCHED; PG8_LDA(At, 1, 0); PG8_STAGE(PG8_SA(0, 1), a2 + hstep, voffA);
            PG8_WAIT_L(8); PG8_BAR; PG8_WAIT_L(0); PG8_MMA(0, 0, At, B0); PG8_BAR; PG8_SCHED;
            PG8_LDB(B1, 1, 1); PG8_STAGE(PG8_SB(1, 0), b3, voffB);
            PG8_BAR; PG8_WAIT_L(0); PG8_MMA(0, 1, At, B1); PG8_BAR;
            PG8_LDA(At, 1, 1); PG8_STAGE(PG8_SA(1, 0), a3, voffA);
            PG8_BAR; PG8_WAIT_L(0); PG8_MMA(1, 0, At, B0); PG8_BAR; PG8_SCHED;
            PG8_STAGE(PG8_SB(1, 1), b3 + hstep, voffB);
            PG8_WAIT_V(6); PG8_BAR; PG8_MMA(1, 1, At, B1); PG8_BAR;
            }
        }
        if constexpr (ALIGN_EPI) { if (wr == 0) PG8_BAR; }
        if constexpr (!Epi::AFTER_DRAIN) { E(acc, cur, wr, wc, fr, fq); S.done(cur); }
        if (!has_next) break;
#pragma unroll
        for (int a = 0; a < 2; ++a)
#pragma unroll
            for (int b = 0; b < 2; ++b)
#pragma unroll
                for (int m = 0; m < 4; ++m)
#pragma unroll
                    for (int n = 0; n < 2; ++n) acc[a][b][m][n] = (f32x4){0.f, 0.f, 0.f, 0.f};
        cur = nxt; cA = nA; cB = nB; ++ui;
        if constexpr (ALIGN_EPI) { if (wr == 1) PG8_BAR; }
    }
    PG8_WAIT_V(0);
    if constexpr (!ALIGN_EPI) { if (wr == 0) PG8_BAR; }
    PG8_BAR;
#undef PG8_SA
#undef PG8_SB
#undef PG8_STAGE
#undef PG8_LDA
#undef PG8_LDB
#undef PG8_MMA
#undef PG8_WAIT_V
#undef PG8_WAIT_L
#undef PG8_BAR
#undef PG8_SCHED
}
}

struct Args {
    const float* x; const float* ln1_g; const float* w_in; const float* diff_lambda; const float* rel_bias; const float* gate_w; const float* gate_b;
    const float* decay_logit; const float* head_gain; const float* w_o; const float* ln2_g; const float* w_up; const float* conv_w; const float* conv_b;
    const float* w_down; const float* final_g;
    float* out; unsigned char* ws; int ph_lo, ph_hi;
};

struct TItem { const float* src; const float* gk; bf16_t* dst; int N, K; float cs; };
__device__ __forceinline__ TItem titem_decode(const Args& a, int it) {
    constexpr int I_IN = (D / 64) * (INW / 32), I_O = (D / 64) * (D / 32), I_UP = (D / 64) * (UPW / 32), I_DN = (DFF / 64) * (D / 32), I_L = I_IN + I_O + I_UP + I_DN;
    const int L = it / I_L; int r = it % I_L; unsigned char* wl = a.ws + WS_W + (size_t)L * W_LAYER; TItem t;
    if (r < I_IN) { const int nblk = INW / 32, kb = r / nblk, n0 = (r % nblk) * 32, k0 = kb * 64;
        t.cs = ((n0 >= GQ && n0 < GK) || (n0 >= SRC_RK && n0 < SRC_RV)) ? 0.125f : 1.f; t.N = INW; t.K = D; t.src = a.w_in + (size_t)L * D * INW + (size_t)k0 * INW + n0; t.gk = a.ln1_g + L * D + k0;
        const int dn = n0 < SRC_GA ? n0 : (n0 < SRC_GA + 32 ? GAF + (n0 - SRC_GA) : n0 - 32);
        t.dst = (bf16_t*)(wl + W_IN) + (size_t)dn * D + k0; return t; }
    r -= I_IN;
    if (r < I_O) { const int nblk = D / 32, kb = r / nblk, n0 = (r % nblk) * 32, k0 = kb * 64;
        t.cs = 1.f; t.N = D; t.K = D; t.src = a.w_o + (size_t)L * D * D + (size_t)k0 * D + n0; t.gk = nullptr; t.dst = (bf16_t*)(wl + W_O) + (size_t)n0 * D + k0; return t; }
    r -= I_O;
    if (r < I_UP) { const int nblk = UPW / 32, kb = r / nblk, n0 = (r % nblk) * 32, k0 = kb * 64;
        const int c = n0 < DFF ? n0 : n0 - DFF; const int dst = (c >> 7) * 256 + (c & 127) + (n0 < DFF ? 0 : 128);
        t.cs = 1.f; t.N = UPW; t.K = D; t.src = a.w_up + (size_t)L * D * UPW + (size_t)k0 * UPW + n0; t.gk = a.ln2_g + L * D + k0; t.dst = (bf16_t*)(wl + W_UP) + (size_t)dst * D + k0; return t; }
    r -= I_UP;
    { const int nblk = D / 32, kb = r / nblk, n0 = (r % nblk) * 32, k0 = kb * 64;
        t.cs = 1.f; t.N = D; t.K = DFF; t.src = a.w_down + (size_t)L * DFF * D + (size_t)k0 * D + n0; t.gk = nullptr; t.dst = (bf16_t*)(wl + W_DN) + (size_t)n0 * DFF + k0; return t; }
}
#define TI_LOAD(R, GV, t) do { const float* sp_ = (t).src + (size_t)(lane >> 5) * (t).N + (lane & 31); \
    _Pragma("unroll") for (int i = 0; i < 32; ++i) R[i] = sp_[(size_t)(2 * i) * (t).N]; \
    if ((t).gk) { const f32x4 g0_ = *(const f32x4*)((t).gk + 8 * (lane & 7)), g1_ = *(const f32x4*)((t).gk + 8 * (lane & 7) + 4); \
        GV[0] = g0_[0] * (t).cs; GV[1] = g0_[1] * (t).cs; GV[2] = g0_[2] * (t).cs; GV[3] = g0_[3] * (t).cs; GV[4] = g1_[0] * (t).cs; GV[5] = g1_[1] * (t).cs; GV[6] = g1_[2] * (t).cs; GV[7] = g1_[3] * (t).cs; } \
    else { _Pragma("unroll") for (int e = 0; e < 8; ++e) GV[e] = (t).cs; } } while (0)
#define TI_PROC(R, GV, t) do { \
    _Pragma("unroll") for (int i = 0; i < 32; ++i) scr[(2 * i + (lane >> 5)) * 33 + (lane & 31)] = R[i]; \
    LDS_WAIT(); asm volatile("" ::: "memory"); \
    const int c_ = lane & 7; \
    _Pragma("unroll") for (int j = 0; j < 4; ++j) { const int n_ = (lane >> 3) + 8 * j; const LAS float* s_ = scr + (8 * c_) * 33 + n_; \
        u32x4 o_; o_.x = cvt_pk_bf16(s_[0 * 33] * GV[0], s_[1 * 33] * GV[1]); o_.y = cvt_pk_bf16(s_[2 * 33] * GV[2], s_[3 * 33] * GV[3]); \
        o_.z = cvt_pk_bf16(s_[4 * 33] * GV[4], s_[5 * 33] * GV[5]); o_.w = cvt_pk_bf16(s_[6 * 33] * GV[6], s_[7 * 33] * GV[7]); \
        *(u32x4*)((t).dst + (size_t)n_ * (t).K + 8 * c_) = o_; } \
    LDS_WAIT(); asm volatile("" ::: "memory"); } while (0)

__device__ __forceinline__ void phase_prologue(const Args& a, LAS unsigned char* lds) {
    const int tid = otid(), lane = tid & 63, wave = tid >> 6, G = gridDim.x;
    LAS float* scr = (LAS float*)(lds + wave * 16384);
    const int gw = blockIdx.x * NWAVE + wave, NGW = G * NWAVE;
    constexpr int I_IN = (D / 64) * (INW / 32), I_O = (D / 64) * (D / 32), I_UP = (D / 64) * (UPW / 32), I_DN = (DFF / 64) * (D / 32), I_L = I_IN + I_O + I_UP + I_DN, I_ALL = DEPTH * I_L;
    { float ra[32], rb[32], ga[8], gb[8]; TItem ta, tb;
        if (gw < I_ALL) { ta = titem_decode(a, gw); TI_LOAD(ra, ga, ta); }
        for (int it = gw; it < I_ALL; it += 2 * NGW) {
            const bool hasB = it + NGW < I_ALL;
            if (hasB) { tb = titem_decode(a, it + NGW); TI_LOAD(rb, gb, tb); }
            TI_PROC(ra, ga, ta);
            if (it + 2 * NGW < I_ALL) { ta = titem_decode(a, it + 2 * NGW); TI_LOAD(ra, ga, ta); }
            if (hasB) TI_PROC(rb, gb, tb);
        } }
    { const int gt = blockIdx.x * NTHR + tid, NT_ = G * NTHR; constexpr int PER = (INP - INW) * D * 2 / 16;
        for (int i = gt; i < DEPTH * PER; i += NT_) { const int L = i / PER, j = i % PER;
            *(u32x4*)(a.ws + WS_W + (size_t)L * W_LAYER + W_IN + (size_t)INW * D * 2 + (size_t)j * 16) = (u32x4){0u, 0u, 0u, 0u}; } }
    { u64_t* ss0 = (u64_t*)(a.ws + WS_SS); bf16_t* xb = (bf16_t*)(a.ws + WS_XB);
        for (int m = gw; m < M; m += NGW) { const f32x4* xr = (const f32x4*)(a.x + (size_t)m * D) + lane; f32x4* orow = (f32x4*)(a.out + (size_t)m * D) + lane; u32x2* brow = (u32x2*)(xb + (size_t)m * D) + lane; float s = 0.f;
#pragma unroll
            for (int j = 0; j < 8; ++j) { const f32x4 v = xr[64 * j]; orow[64 * j] = v; s += (v[0] * v[0] + v[1] * v[1]) + (v[2] * v[2] + v[3] * v[3]);
                u32x2 w; w.x = cvt_pk_bf16(v[0], v[1]); w.y = cvt_pk_bf16(v[2], v[3]); brow[64 * j] = w; }
            s = wave_sum(s); if (lane == 0) ss0[m] = (u64_t)(s * SS_FX + 0.5f); } }
    { const int gt = blockIdx.x * NTHR + tid, NT_ = G * NTHR;
        f32x2* rope = (f32x2*)(a.ws + WS_ROPE);
        for (int i = gt; i < T * 32; i += NT_) { const int pos = i >> 5, f = i & 31;
            const float ex = (float)f * (1.0f / 31.0f); const float inv = 1.0f / __builtin_amdgcn_exp2f(ex * 13.287712379549449f);
            const float ang = (float)pos * inv; const double rev = (double)ang * 0.15915494309189535; const float fr = (float)(rev - __builtin_rint(rev));
            rope[i] = (f32x2){__builtin_amdgcn_cosf(fr), __builtin_amdgcn_sinf(fr)}; }
        float* btab = (float*)(a.ws + WS_BTAB);
        for (int i = gt; i < 8 * BTAB_N; i += NT_) { const int h = i / BTAB_N, rel = i % BTAB_N - BTAB_OFF; const int n = rel < 0 ? -rel : rel;
            int bk = n; if (n >= 8) { bk = 8 + (n >= 12) + (n >= 16) + (n >= 23) + (n >= 32) + (n >= 46) + (n >= 64) + (n >= 91); }
            if (rel > 0) bk += 16; btab[i] = a.rel_bias[bk * 8 + h] * 8.0f; }
        if (gt < DEPTH) { const float* lp = a.diff_lambda + gt * 256; float s1 = 0.f, s2 = 0.f; for (int j = 0; j < 64; ++j) { s1 += lp[j] * lp[64 + j]; s2 += lp[128 + j] * lp[192 + j]; }
            float e1 = __expf(s1), e2 = __expf(s2); asm volatile("" : "+v"(e1), "+v"(e2));
            const float li = 0.8f - 0.6f * __expf(-0.3f * (float)gt); ((float*)(a.ws + WS_LAM))[gt] = (e1 - e2) + li; } }
}

namespace att {
constexpr int LD = INP;
constexpr float SCALE = 0.125f, THR = 8.f;
constexpr int SHM_V = 64 * 128 * 2, SHM_K = 64 * 64 * 2;
constexpr int NBUF = 3;
constexpr int L_V = 0, L_K = NBUF * SHM_V, L_WS = L_K + NBUF * SHM_K, L_TAB = L_WS + NWAVE * 64 * 4;
#define KSWZ64(row, colB) ((row) * 128 + ((colB) ^ ((((row) >> 1) & 7) << 4)))
#define SBAR() __builtin_amdgcn_sched_barrier(0)
__device__ __forceinline__ int crow(int r, int hi) { return (r & 3) + 8 * (r >> 2) + 4 * hi; }
#define MX3(a, b, c) __builtin_fmaxf(__builtin_fmaxf((a), (b)), (c))
__device__ __forceinline__ void partialSM(f32x16& p0, f32x16& p1, float& m_reg, float& mn, float& alpha, float boff) {
    constexpr float C = SCALE * 1.4426950408889634f;
    float a = MX3(p0[0], p0[1], p1[0]), b = MX3(p0[2], p0[3], p1[1]); a = MX3(a, p1[2], p1[3]);
#pragma unroll
    for (int r = 4; r < 16; r += 4) { a = MX3(a, p0[r], p0[r + 1]); b = MX3(b, p0[r + 2], p0[r + 3]); a = MX3(a, p1[r], p1[r + 1]); b = MX3(b, p1[r + 2], p1[r + 3]); }
    float pmax = __builtin_fmaxf(a, b);
    { auto rr = __builtin_amdgcn_permlane32_swap(__float_as_uint(pmax), __float_as_uint(pmax), false, false);
      pmax = fmaxf(__uint_as_float(rr[0]), __uint_as_float(rr[1])) + boff; }
    if (__builtin_expect(__all(pmax - m_reg <= THR / SCALE), 1)) { mn = m_reg; alpha = 1.f; }
    else { mn = fmaxf(m_reg, pmax); alpha = __builtin_amdgcn_exp2f((m_reg - mn) * C); m_reg = mn; }
    const float mnC = (boff - mn) * C;
#pragma unroll
    for (int r = 0; r < 16; ++r) p0[r] = fmaf(p0[r], C, mnC);
#pragma unroll
    for (int r = 0; r < 16; ++r) p1[r] = fmaf(p1[r], C, mnC);
#pragma unroll
    for (int r = 0; r < 16; ++r) p0[r] = __builtin_amdgcn_exp2f(p0[r]);
}
__device__ __forceinline__ void finishSM(f32x16& p0, f32x16& p1, float alpha, float& l_reg, bf16x8& pa0, bf16x8& pa1, bf16x8& pa2, bf16x8& pa3) {
#pragma unroll
    for (int r = 0; r < 16; ++r) p1[r] = __builtin_amdgcn_exp2f(p1[r]);
    float ps = 0;
#pragma unroll
    for (int r = 0; r < 16; ++r) ps += p0[r];
#pragma unroll
    for (int r = 0; r < 16; ++r) ps += p1[r];
    { auto rr = __builtin_amdgcn_permlane32_swap(__float_as_uint(ps), __float_as_uint(ps), false, false);
      ps = __uint_as_float(rr[0]) + __uint_as_float(rr[1]); }
    l_reg = l_reg * alpha + ps;
#define PK4(P, BASE, OUT) do { unsigned a0 = cvt_pk_bf16(P[BASE + 0], P[BASE + 1]), a1 = cvt_pk_bf16(P[BASE + 2], P[BASE + 3]);   \
    unsigned b0 = cvt_pk_bf16(P[BASE + 4], P[BASE + 5]), b1 = cvt_pk_bf16(P[BASE + 6], P[BASE + 7]);                              \
    auto r0 = __builtin_amdgcn_permlane32_swap(a0, b0, false, false); auto r1 = __builtin_amdgcn_permlane32_swap(a1, b1, false, false); \
    u32x4 w = {r0[0], r1[0], r0[1], r1[1]}; OUT = __builtin_bit_cast(bf16x8, w); } while (0)
    PK4(p0, 0, pa0); PK4(p0, 8, pa1); PK4(p1, 0, pa2); PK4(p1, 8, pa3);
#undef PK4
}
__device__ __forceinline__ float qkt(f32x16& p0, f32x16& p1, const LAS char* Ks, const bf16x8* qr, int r32, int hi, int dlt, float cL, float cR, const LAS float* tabL) {
    bf16x8 b0[4], b1[4];
#pragma unroll
    for (int d0 = 0; d0 < 4; ++d0) { const int cb = d0 * 32 + hi * 16;
        b0[d0] = *(const LAS bf16x8*)(Ks + KSWZ64(r32, cb)); b1[d0] = *(const LAS bf16x8*)(Ks + KSWZ64(32 + r32, cb)); }
    if (dlt <= -191 || dlt >= 159) {
        const f32x16 z = f32x16{};
        p0 = __builtin_amdgcn_mfma_f32_32x32x16_bf16(b0[0], qr[0], z, 0, 0, 0); p1 = __builtin_amdgcn_mfma_f32_32x32x16_bf16(b1[0], qr[0], z, 0, 0, 0);
#pragma unroll
        for (int d0 = 1; d0 < 4; ++d0) { p0 = __builtin_amdgcn_mfma_f32_32x32x16_bf16(b0[d0], qr[d0], p0, 0, 0, 0); p1 = __builtin_amdgcn_mfma_f32_32x32x16_bf16(b1[d0], qr[d0], p1, 0, 0, 0); }
        return dlt < 0 ? cL : cR;
    }
    const LAS float* tp = tabL + (dlt + BTAB_OFF + 4 * hi - r32);
#pragma unroll
    for (int r = 0; r < 16; ++r) { p0[r] = tp[(r & 3) + 8 * (r >> 2)]; p1[r] = tp[32 + (r & 3) + 8 * (r >> 2)]; }
    asm volatile("s_waitcnt lgkmcnt(0)" ::: "memory");
#pragma unroll
    for (int d0 = 0; d0 < 4; ++d0) { p0 = __builtin_amdgcn_mfma_f32_32x32x16_bf16(b0[d0], qr[d0], p0, 0, 0, 0); p1 = __builtin_amdgcn_mfma_f32_32x32x16_bf16(b1[d0], qr[d0], p1, 0, 0, 0); }
    return 0.f;
}
__device__ __forceinline__ int v_st(int k, int c) { const int kk = (k & ~0xC) | ((k & 4) << 1) | ((k & 8) >> 1); return ((kk >> 3) * 4 + (c >> 5)) * 512 + ((kk & 7) * 32 + (c & 31)) * 2; }
__device__ __forceinline__ int v_rd_base(int lane) { return ((lane & 3) << 3) | (((lane >> 2) & 3) << 6) | (((lane >> 4) & 1) << 5) | (((lane >> 5) & 1) << 8); }
constexpr int v_rd_off(int d0, int ks, int half) { return d0 * 512 + ks * 4096 + half * 2048; }
template <int OFF> __device__ __forceinline__ s16x4 tr_read(int vb) {
    s16x4 r; asm volatile("ds_read_b64_tr_b16 %0, %1 offset:%2" : "=&v"(r) : "v"(vb), "i"(OFF) : "memory"); return r;
}
template <int D0> __device__ __forceinline__ void pv_one(f32x16& od, int vb, bf16x8 pa0, bf16x8 pa1, bf16x8 pa2, bf16x8 pa3) {
    const s16x4 l0 = tr_read<v_rd_off(D0, 0, 0)>(vb), h0 = tr_read<v_rd_off(D0, 0, 1)>(vb), l1 = tr_read<v_rd_off(D0, 1, 0)>(vb), h1 = tr_read<v_rd_off(D0, 1, 1)>(vb);
    const s16x4 l2 = tr_read<v_rd_off(D0, 2, 0)>(vb), h2 = tr_read<v_rd_off(D0, 2, 1)>(vb), l3 = tr_read<v_rd_off(D0, 3, 0)>(vb), h3 = tr_read<v_rd_off(D0, 3, 1)>(vb);
    asm volatile("s_waitcnt lgkmcnt(0)" ::: "memory"); SBAR();
#define PK(L, H) (bf16x8){L[0], L[1], L[2], L[3], H[0], H[1], H[2], H[3]}
    od = __builtin_amdgcn_mfma_f32_32x32x16_bf16(pa0, PK(l0, h0), od, 0, 0, 0);
    od = __builtin_amdgcn_mfma_f32_32x32x16_bf16(pa1, PK(l1, h1), od, 0, 0, 0);
    od = __builtin_amdgcn_mfma_f32_32x32x16_bf16(pa2, PK(l2, h2), od, 0, 0, 0);
    od = __builtin_amdgcn_mfma_f32_32x32x16_bf16(pa3, PK(l3, h3), od, 0, 0, 0);
#undef PK
}
__device__ __forceinline__ void pv_d0(f32x16* o, int vb, bf16x8 pa0, bf16x8 pa1, bf16x8 pa2, bf16x8 pa3) {
    pv_one<0>(o[0], vb, pa0, pa1, pa2, pa3); pv_one<1>(o[1], vb, pa0, pa1, pa2, pa3); pv_one<2>(o[2], vb, pa0, pa1, pa2, pa3); pv_one<3>(o[3], vb, pa0, pa1, pa2, pa3);
}

__device__ __forceinline__ void attn_unit(int b, int h, int qb, const bf16_t* __restrict__ proj, const float* __restrict__ btab, float lam, float outscale,
                                          const float* __restrict__ gain, float* o1scr, bf16_t* merged, LAS char* lds) {
    const int tid = otid(), wid = __builtin_amdgcn_readfirstlane(tid >> 6), lane = tid & 63, r32 = lane & 31, hi = lane >> 5;
    const long rowbase = (long)b * T; const int qw = qb * 256 + wid * 32;
    LAS char* V_lds = lds + L_V; LAS char* K_lds = lds + L_K;
    LAS float* wsl = (LAS float*)(lds + L_WS) + wid * 64; LAS float* li_l = wsl; LAS float* al_l = wsl + 32;
    LAS float* tabL = (LAS float*)(lds + L_TAB);
    __syncthreads();
    if (tid < BTAB_N) tabL[tid] = btab[h * BTAB_N + tid];
    __syncthreads();
    const float cL = tabL[0], cR = tabL[BTAB_N - 1];
    unsigned koff, voffA, voffB;
    { const int row = wid * 8 + (lane >> 3), c16 = (lane & 7) ^ ((row >> 1) & 7); koff = (unsigned)((row * LD + c16 * 8) * 2);
      const int within = lane & 31;
#pragma unroll
      for (int i = 0; i < 2; ++i) { const int sub = (2 * wid + i) * 2 + (lane >> 5); const int kk = (sub >> 2) * 8 + (within >> 2);
          const int k = (kk & ~0xC) | ((kk & 4) << 1) | ((kk & 8) >> 1), c = (sub & 3) * 32 + (within & 3) * 8;
          const unsigned o = (unsigned)((k * LD + c) * 2); if (i == 0) voffA = o; else voffB = o; } }
    const int vb0 = (int)(unsigned)(uintptr_t)V_lds + v_rd_base(lane);
    const bf16_t* Vh = proj + rowbase * LD + OV + h * 128;
#pragma unroll 1
    for (int s = 0; s < 2; ++s) {
        const int hq = 2 * h + s;
        const bf16_t* Kh = proj + rowbase * LD + OKK + hq * 64;
        const bf16_t* Qw = proj + (rowbase + qw + r32) * LD + OQ + hq * 64 + hi * 8;
        float m_reg = -1e30f, l_reg = 0; f32x16 o[4]; bf16x8 qr[4];
#pragma unroll
        for (int d0 = 0; d0 < 4; ++d0) { o[d0] = f32x16{}; qr[d0] = *(const bf16x8*)(Qw + d0 * 16); }
#define DMA_TILE(t, buf) do { const char* vt_ = (const char*)Vh + (size_t)(t) * (64 * LD * 2); const char* kt_ = (const char*)Kh + (size_t)(t) * (64 * LD * 2); \
        __builtin_amdgcn_global_load_lds((const unsigned*)(kt_ + koff), (LAS unsigned*)(K_lds + (buf) * SHM_K + wid * 1024), 16, 0, 0); \
        __builtin_amdgcn_global_load_lds((const unsigned*)(vt_ + voffA), (LAS unsigned*)(V_lds + (buf) * SHM_V + (2 * wid) * 1024), 16, 0, 0); \
        __builtin_amdgcn_global_load_lds((const unsigned*)(vt_ + voffB), (LAS unsigned*)(V_lds + (buf) * SHM_V + (2 * wid + 1) * 1024), 16, 0, 0); } while (0)
#define WAITBAR(N) asm volatile("s_waitcnt vmcnt(" #N ") lgkmcnt(0)\n\ts_barrier" ::: "memory")
#define RESC(a) do { if (__any((a) < 1.f)) { if (hi == 0) al_l[r32] = (a); asm volatile("s_waitcnt lgkmcnt(0)" ::: "memory"); \
        _Pragma("unroll") for (int d = 0; d < 4; ++d) _Pragma("unroll") for (int r = 0; r < 16; ++r) o[d][r] *= al_l[crow(r, hi)]; } } while (0)
        f32x16 pA0, pA1, pB0, pB1; float mnA, mnB, alA, alB, bo; bf16x8 pa0, pa1, pa2, pa3; constexpr int NT = T / 64;
        asm volatile("s_waitcnt vmcnt(0) lgkmcnt(0)" ::: "memory"); __syncthreads();
        DMA_TILE(0, 0); DMA_TILE(1, 1);
        WAITBAR(3);
        bo = qkt(pA0, pA1, K_lds, qr, r32, hi, 0 - qw, cL, cR, tabL); partialSM(pA0, pA1, m_reg, mnA, alA, bo);
        int bc = 1, bp = 0, bn = 2;
#define ROT() do { const int t_ = bp; bp = bc; bc = bn; bn = t_; } while (0)
#pragma unroll 1
        for (int j = 1; j + 1 < NT; j += 2) {
            WAITBAR(0);
            DMA_TILE(j + 1, bn);
            SBAR(); bo = qkt(pB0, pB1, K_lds + bc * SHM_K, qr, r32, hi, j * 64 - qw, cL, cR, tabL);
            finishSM(pA0, pA1, alA, l_reg, pa0, pa1, pa2, pa3); SBAR();
            pv_d0(o, vb0 + bp * SHM_V, pa0, pa1, pa2, pa3); partialSM(pB0, pB1, m_reg, mnB, alB, bo);
            RESC(alB); ROT();
            WAITBAR(0);
            if (j + 2 < NT) DMA_TILE(j + 2, bn);
            SBAR(); bo = qkt(pA0, pA1, K_lds + bc * SHM_K, qr, r32, hi, (j + 1) * 64 - qw, cL, cR, tabL);
            finishSM(pB0, pB1, alB, l_reg, pa0, pa1, pa2, pa3); SBAR();
            pv_d0(o, vb0 + bp * SHM_V, pa0, pa1, pa2, pa3); partialSM(pA0, pA1, m_reg, mnA, alA, bo);
            RESC(alA); ROT();
        }
        WAITBAR(0);
        SBAR(); bo = qkt(pB0, pB1, K_lds + bc * SHM_K, qr, r32, hi, (NT - 1) * 64 - qw, cL, cR, tabL);
        finishSM(pA0, pA1, alA, l_reg, pa0, pa1, pa2, pa3); SBAR();
        pv_d0(o, vb0 + bp * SHM_V, pa0, pa1, pa2, pa3); partialSM(pB0, pB1, m_reg, mnB, alB, bo);
        RESC(alB);
        finishSM(pB0, pB1, alB, l_reg, pa0, pa1, pa2, pa3); SBAR();
        pv_d0(o, vb0 + bc * SHM_V, pa0, pa1, pa2, pa3);
#undef ROT
#undef DMA_TILE
#undef WAITBAR
#undef RESC
        if (hi == 0) li_l[r32] = l_reg; asm volatile("s_waitcnt lgkmcnt(0)" ::: "memory");
        float rli[16];
#pragma unroll
        for (int r = 0; r < 16; ++r) rli[r] = __builtin_amdgcn_rcpf(li_l[crow(r, hi)]);
        int tl = tid; asm volatile("" : "+v"(tl));
        f32x4* o1p = (f32x4*)(o1scr + (size_t)tl * 64);
        if (s == 0) {
#pragma unroll
            for (int d0 = 0; d0 < 4; ++d0)
#pragma unroll
                for (int r4 = 0; r4 < 4; ++r4)
                    o1p[d0 * 4 + r4] = (f32x4){o[d0][4 * r4] * rli[4 * r4], o[d0][4 * r4 + 1] * rli[4 * r4 + 1], o[d0][4 * r4 + 2] * rli[4 * r4 + 2], o[d0][4 * r4 + 3] * rli[4 * r4 + 3]};
        } else {
#pragma unroll
            for (int d0 = 0; d0 < 4; ++d0)
#pragma unroll
                for (int r4 = 0; r4 < 4; ++r4) { const f32x4 p = o1p[d0 * 4 + r4];
#pragma unroll
                    for (int e = 0; e < 4; ++e) o[d0][4 * r4 + e] = p[e] - lam * (o[d0][4 * r4 + e] * rli[4 * r4 + e]); }
            float ssq[16];
#pragma unroll
            for (int r = 0; r < 16; ++r) { float a2 = 0.f;
#pragma unroll
                for (int d0 = 0; d0 < 4; ++d0) a2 += o[d0][r] * o[d0][r];
                a2 += __shfl_xor(a2, 1); a2 += __shfl_xor(a2, 2); a2 += __shfl_xor(a2, 4); a2 += __shfl_xor(a2, 8); a2 += __shfl_xor(a2, 16);
                ssq[r] = __builtin_amdgcn_rsqf(a2 * (1.0f / 128.0f) + EPS) * outscale; }
            const int r32l = tl & 31, hil = (tl >> 5) & 1;
            float gn[4];
#pragma unroll
            for (int d0 = 0; d0 < 4; ++d0) gn[d0] = gain[h * 128 + d0 * 32 + r32l];
            bf16_t* Ow = merged + (rowbase + qw + 4 * hil) * D + h * 128 + r32l;
#pragma unroll
            for (int r = 0; r < 16; ++r) { bf16_t* orp = Ow + (long)((r & 3) + 8 * (r >> 2)) * D;
#pragma unroll
                for (int d0 = 0; d0 < 4; ++d0) orp[d0 * 32] = (bf16_t)f2bf(o[d0][r] * ssq[r] * gn[d0]); }
        }
    }
}
#undef SBAR
}

namespace lin {
constexpr int LD = INP, PT = 72;
constexpr int L_CUM = 0, L_VT = 32768, L_QK = L_VT + 128 * PT * 2, L_P = L_QK + 4 * 64 * PT * 2, L_OL = L_QK, OLP = 132;
__device__ __forceinline__ int crow(int r, int hi) { return (r & 3) + 8 * (r >> 2) + 4 * hi; }
__device__ __forceinline__ int seqidx(int b, int hl, int dir, int c) { return ((b * 8 + hl) * 2 + dir) * 64 + c; }

__device__ __forceinline__ void build_cum(const Args& a, int L, int hl, long R0, const bf16_t* __restrict__ proj, LAS unsigned char* lds) {
    const int tid = otid(); LAS float* cum = (LAS float*)(lds + L_CUM);
    const int k = tid & 63, dir = (tid >> 6) & 1, isub = tid >> 7;
    if (hl < 4) {
        float gw[16];
#pragma unroll
        for (int r = 0; r < 16; ++r) gw[r] = a.gate_w[((size_t)(L * 2 + dir) * 16 + r) * 256 + hl * 64 + k];
        const float gb = a.gate_b[(L * 2 + dir) * 256 + hl * 64 + k];
#pragma unroll 4
        for (int it = 0; it < 16; ++it) { const int i = isub + 4 * it; const bf16_t* ga = proj + (R0 + i) * LD + GAF + dir * 16;
            const u32x4 g0 = *(const u32x4*)ga, g1 = *(const u32x4*)(ga + 8);
            float x = gb;
            x += gw[0] * bflo(g0.x) + gw[1] * bfhi(g0.x) + gw[2] * bflo(g0.y) + gw[3] * bfhi(g0.y) + gw[4] * bflo(g0.z) + gw[5] * bfhi(g0.z) + gw[6] * bflo(g0.w) + gw[7] * bfhi(g0.w);
            x += gw[8] * bflo(g1.x) + gw[9] * bfhi(g1.x) + gw[10] * bflo(g1.y) + gw[11] * bfhi(g1.y) + gw[12] * bflo(g1.z) + gw[13] * bfhi(g1.z) + gw[14] * bflo(g1.w) + gw[15] * bfhi(g1.w);
            cum[(dir * 64 + i) * 64 + k] = logsigmoidf(x) * (1.0f / 16.0f); }
    } else {
        const float lg = logsigmoidf(a.decay_logit[(L * 2 + dir) * 4 + (hl - 4)]);
#pragma unroll 4
        for (int it = 0; it < 16; ++it) cum[(dir * 64 + isub + 4 * it) * 64 + k] = lg;
    }
    __syncthreads();
    if (tid < 128) { const int d = tid >> 6; float run = 0.f;
        if (d == 0) {
#pragma unroll 8
            for (int i = 0; i < 64; ++i) { run += cum[i * 64 + k]; cum[i * 64 + k] = run; }
        } else {
#pragma unroll 8
            for (int i = 63; i >= 0; --i) { run += cum[(64 + i) * 64 + k]; cum[(64 + i) * 64 + k] = run; }
        } }
    __syncthreads();
}
__device__ __forceinline__ void load_qk16(const Args& a, const bf16_t* __restrict__ src, int hl, int pos, int g, float (&va)[8], float (&vb)[8]) {
    const u32x4 wa = *(const u32x4*)(src + g * 8), wb = *(const u32x4*)(src + 32 + g * 8);
    va[0] = bflo(wa.x); va[1] = bfhi(wa.x); va[2] = bflo(wa.y); va[3] = bfhi(wa.y); va[4] = bflo(wa.z); va[5] = bfhi(wa.z); va[6] = bflo(wa.w); va[7] = bfhi(wa.w);
    vb[0] = bflo(wb.x); vb[1] = bfhi(wb.x); vb[2] = bflo(wb.y); vb[3] = bfhi(wb.y); vb[4] = bflo(wb.z); vb[5] = bfhi(wb.z); vb[6] = bflo(wb.w); vb[7] = bfhi(wb.w);
    if (hl >= 4) { const f32x2* rp = (const f32x2*)(a.ws + WS_ROPE) + pos * 32 + g * 8;
#pragma unroll
        for (int e = 0; e < 8; ++e) { const f32x2 cs = rp[e]; const float x1 = va[e], x2 = vb[e]; va[e] = x1 * cs.x - x2 * cs.y; vb[e] = x1 * cs.y + x2 * cs.x; } }
}
__device__ __forceinline__ u32x4 pack8(const float (&v)[8]) { u32x4 w; w.x = cvt_pk_bf16(v[0], v[1]); w.y = cvt_pk_bf16(v[2], v[3]); w.z = cvt_pk_bf16(v[4], v[5]); w.w = cvt_pk_bf16(v[6], v[7]); return w; }

__device__ __forceinline__ void r1_item(const Args& a, int L, int item, LAS unsigned char* lds) {
    const int tid = otid(), wid = tid >> 6, lane = tid & 63, r32 = lane & 31, hi = lane >> 5;
    const int b = item >> 9, hl = (item >> 6) & 7, c = item & 63; const long R0 = (long)b * T + c * 64;
    const bf16_t* proj = (const bf16_t*)(a.ws + WS_PROJ);
    __syncthreads();
    build_cum(a, L, hl, R0, proj, lds);
    LAS float* cum = (LAS float*)(lds + L_CUM);
    LAS bf16_t* VT = (LAS bf16_t*)(lds + L_VT); LAS bf16_t* KeT = (LAS bf16_t*)(lds + L_QK);
    if (tid < 256) { const int i = (tid >> 2) & 63, g = tid & 3; const int kcol = hl < 4 ? GK + hl * 64 : RK + (hl - 4) * 64;
        float va[8], vb[8]; load_qk16(a, proj + (R0 + i) * LD + kcol, hl, c * 64 + i, g, va, vb);
#pragma unroll
        for (int dir = 0; dir < 2; ++dir) { const int lastrow = dir == 0 ? 63 : 64;
#pragma unroll
            for (int e = 0; e < 8; ++e) { const int ka = g * 8 + e, kb = 32 + g * 8 + e;
                const float wa = __expf(cum[lastrow * 64 + ka] - cum[(dir * 64 + i) * 64 + ka]), wb = __expf(cum[lastrow * 64 + kb] - cum[(dir * 64 + i) * 64 + kb]);
                KeT[(dir * 64 + ka) * PT + i] = (bf16_t)f2bf(va[e] * wa); KeT[(dir * 64 + kb) * PT + i] = (bf16_t)f2bf(vb[e] * wb); } }
    } else { const int t2 = tid - 256, j = t2 >> 2, vg = t2 & 3; const int vcol = hl < 4 ? GV + hl * 128 : RV + (hl - 4) * 128;
        const bf16_t* vp = proj + (R0 + j) * LD + vcol + vg * 32;
#pragma unroll
        for (int q = 0; q < 4; ++q) { const u32x4 w = *(const u32x4*)(vp + q * 8); const int v0 = vg * 32 + q * 8;
            VT[(v0 + 0) * PT + j] = (bf16_t)(w.x & 0xffff); VT[(v0 + 1) * PT + j] = (bf16_t)(w.x >> 16); VT[(v0 + 2) * PT + j] = (bf16_t)(w.y & 0xffff); VT[(v0 + 3) * PT + j] = (bf16_t)(w.y >> 16);
            VT[(v0 + 4) * PT + j] = (bf16_t)(w.z & 0xffff); VT[(v0 + 5) * PT + j] = (bf16_t)(w.z >> 16); VT[(v0 + 6) * PT + j] = (bf16_t)(w.w & 0xffff); VT[(v0 + 7) * PT + j] = (bf16_t)(w.w >> 16); } }
    __syncthreads();
    { const int dir = wid >> 2, mt = wid & 3; f32x16 acc0 = f32x16{}, acc1 = f32x16{};
#pragma unroll
        for (int ks = 0; ks < 4; ++ks) { const bf16x8 av = *(const LAS bf16x8*)(VT + (mt * 32 + r32) * PT + ks * 16 + hi * 8);
            const bf16x8 b0 = *(const LAS bf16x8*)(KeT + (dir * 64 + r32) * PT + ks * 16 + hi * 8), b1 = *(const LAS bf16x8*)(KeT + (dir * 64 + 32 + r32) * PT + ks * 16 + hi * 8);
            acc0 = __builtin_amdgcn_mfma_f32_32x32x16_bf16(av, b0, acc0, 0, 0, 0); acc1 = __builtin_amdgcn_mfma_f32_32x32x16_bf16(av, b1, acc1, 0, 0, 0); }
        bf16_t* kvt = (bf16_t*)(a.ws + WS_KVT) + (size_t)seqidx(b, hl, dir, c) * 8192;
#pragma unroll
        for (int r = 0; r < 16; ++r) { const int v = mt * 32 + crow(r, hi); kvt[v * 64 + r32] = (bf16_t)f2bf(acc0[r]); kvt[v * 64 + 32 + r32] = (bf16_t)f2bf(acc1[r]); } }
    if (tid < 128) { const int dir = tid >> 6, k = tid & 63; ((float*)(a.ws + WS_DEC))[(size_t)seqidx(b, hl, dir, c) * 64 + k] = __expf(cum[(dir == 0 ? 63 : 64) * 64 + k]); }
}

__device__ __forceinline__ void scan_phase(const Args& a) {
    const bf16_t* kvt = (const bf16_t*)(a.ws + WS_KVT); const float* dec = (const float*)(a.ws + WS_DEC); bf16_t* st = (bf16_t*)(a.ws + WS_ST);
    const int tid = otid();
    for (int g = blockIdx.x * NTHR + tid; g < 32 * 4096; g += gridDim.x * NTHR) {
        const int seq = g >> 12, e2 = g & 4095, v = e2 >> 5, k2 = (e2 & 31) * 2, dir = seq & 1; float s0 = 0.f, s1 = 0.f;
#pragma unroll 8
        for (int step = 0; step < 64; ++step) { const int c = dir ? 63 - step : step; const size_t idx = (size_t)seq * 64 + c;
            const unsigned kw = *(const unsigned*)(kvt + idx * 8192 + v * 64 + k2); const f32x2 kv = (f32x2){bflo(kw), bfhi(kw)}; const f32x2 d = *(const f32x2*)(dec + idx * 64 + k2);
            *(unsigned*)(st + idx * 8192 + v * 64 + k2) = cvt_pk_bf16(s0, s1);
            s0 = d.x * s0 + kv.x; s1 = d.y * s1 + kv.y; }
    }
}

__device__ __forceinline__ void r3_item(const Args& a, int L, int item, LAS unsigned char* lds) {
    const int tid = otid(), wid = tid >> 6, lane = tid & 63, r32 = lane & 31, hi = lane >> 5;
    const int b = item >> 9, hl = (item >> 6) & 7, c = item & 63; const long R0 = (long)b * T + c * 64;
    const bf16_t* proj = (const bf16_t*)(a.ws + WS_PROJ);
    __syncthreads();
    build_cum(a, L, hl, R0, proj, lds);
    LAS float* cum = (LAS float*)(lds + L_CUM);
    LAS bf16_t* VT = (LAS bf16_t*)(lds + L_VT); LAS bf16_t* QK = (LAS bf16_t*)(lds + L_QK);
    LAS bf16_t* P = (LAS bf16_t*)(lds + L_P);
    { const int mat = tid >> 8, i = (tid >> 2) & 63, g = tid & 3;
        const int col = mat == 0 ? (hl < 4 ? GQ + hl * 64 : RQ + (hl - 4) * 64) : (hl < 4 ? GK + hl * 64 : RK + (hl - 4) * 64);
        float va[8], vb[8]; load_qk16(a, proj + (R0 + i) * LD + col, hl, c * 64 + i, g, va, vb);
        const float sg = mat == 0 ? 1.f : -1.f;
#pragma unroll
        for (int dir = 0; dir < 2; ++dir) { float ta[8], tb[8];
#pragma unroll
            for (int e = 0; e < 8; ++e) { ta[e] = va[e] * __expf(sg * cum[(dir * 64 + i) * 64 + g * 8 + e]); tb[e] = vb[e] * __expf(sg * cum[(dir * 64 + i) * 64 + 32 + g * 8 + e]); }
            LAS bf16_t* dst = QK + ((dir * 2 + mat) * 64 + i) * PT;
            *(LAS u32x4*)(dst + g * 8) = pack8(ta); *(LAS u32x4*)(dst + 32 + g * 8) = pack8(tb); } }
    { const int j = tid >> 3, vg = tid & 7; const int vcol = hl < 4 ? GV + hl * 128 : RV + (hl - 4) * 128;
        const bf16_t* vp = proj + (R0 + j) * LD + vcol + vg * 16;
#pragma unroll
        for (int q = 0; q < 2; ++q) { const u32x4 w = *(const u32x4*)(vp + q * 8); const int v0 = vg * 16 + q * 8;
            VT[(v0 + 0) * PT + j] = (bf16_t)(w.x & 0xffff); VT[(v0 + 1) * PT + j] = (bf16_t)(w.x >> 16); VT[(v0 + 2) * PT + j] = (bf16_t)(w.y & 0xffff); VT[(v0 + 3) * PT + j] = (bf16_t)(w.y >> 16);
            VT[(v0 + 4) * PT + j] = (bf16_t)(w.z & 0xffff); VT[(v0 + 5) * PT + j] = (bf16_t)(w.z >> 16); VT[(v0 + 6) * PT + j] = (bf16_t)(w.w & 0xffff); VT[(v0 + 7) * PT + j] = (bf16_t)(w.w >> 16); } }
    __syncthreads();
    { const int dir = wid >> 2, it = (wid >> 1) & 1, jt = wid & 1; f32x16 sc = f32x16{};
        const LAS bf16_t* Qt = QK + ((dir * 2 + 0) * 64) * PT; const LAS bf16_t* Kt = QK + ((dir * 2 + 1) * 64) * PT;
#pragma unroll
        for (int ks = 0; ks < 4; ++ks) { const bf16x8 av = *(const LAS bf16x8*)(Kt + (jt * 32 + r32) * PT + ks * 16 + hi * 8), bv = *(const LAS bf16x8*)(Qt + (it * 32 + r32) * PT + ks * 16 + hi * 8);
            sc = __builtin_amdgcn_mfma_f32_32x32x16_bf16(av, bv, sc, 0, 0, 0); }
        const int i = it * 32 + r32;
#pragma unroll
        for (int g4 = 0; g4 < 4; ++g4) { float v[4];
#pragma unroll
            for (int e = 0; e < 4; ++e) { const int j = jt * 32 + 8 * g4 + 4 * hi + e; const bool keep = dir == 0 ? (j <= i) : (j >= i); v[e] = keep ? sc[g4 * 4 + e] : 0.f; }
            u32x2 w; w.x = cvt_pk_bf16(v[0], v[1]); w.y = cvt_pk_bf16(v[2], v[3]);
            *(LAS u32x2*)(P + (dir * 64 + i) * PT + jt * 32 + 8 * g4 + 4 * hi) = w; } }
    __syncthreads();
    { const int it = wid >> 2, vt = wid & 3; f32x16 acc = f32x16{};
        bf16x8 stf[2][4];
#pragma unroll
        for (int dir = 0; dir < 2; ++dir) { const bf16_t* stp = (const bf16_t*)(a.ws + WS_ST) + (size_t)seqidx(b, hl, dir, c) * 8192 + (vt * 32 + r32) * 64 + hi * 8;
#pragma unroll
            for (int ks = 0; ks < 4; ++ks) stf[dir][ks] = *(const bf16x8*)(stp + ks * 16); }
#pragma unroll
        for (int dir = 0; dir < 2; ++dir) { const LAS bf16_t* Qt = QK + ((dir * 2 + 0) * 64) * PT;
#pragma unroll
            for (int ks = 0; ks < 4; ++ks) { const bf16x8 av = *(const LAS bf16x8*)(P + (dir * 64 + it * 32 + r32) * PT + ks * 16 + hi * 8), bv = *(const LAS bf16x8*)(VT + (vt * 32 + r32) * PT + ks * 16 + hi * 8);
                acc = __builtin_amdgcn_mfma_f32_32x32x16_bf16(av, bv, acc, 0, 0, 0); }
#pragma unroll
            for (int ks = 0; ks < 4; ++ks) { const bf16x8 av = *(const LAS bf16x8*)(Qt + (it * 32 + r32) * PT + ks * 16 + hi * 8), bv = stf[dir][ks];
                acc = __builtin_amdgcn_mfma_f32_32x32x16_bf16(av, bv, acc, 0, 0, 0); } }
        __syncthreads();
        LAS float* OL = (LAS float*)(lds + L_OL);
#pragma unroll
        for (int r = 0; r < 16; ++r) OL[(it * 32 + crow(r, hi)) * OLP + vt * 32 + r32] = acc[r]; }
    __syncthreads();
    { const int row = tid >> 3, seg = tid & 7; const LAS float* op = (const LAS float*)(lds + L_OL) + row * OLP + seg * 16; float ov[16]; float s = 0.f;
#pragma unroll
        for (int e = 0; e < 16; ++e) { ov[e] = op[e]; s += ov[e] * ov[e]; }
        s += __shfl_xor(s, 1); s += __shfl_xor(s, 2); s += __shfl_xor(s, 4);
        const float rs = rsqrtf(s * (1.0f / 128.0f) + EPS);
        const int gcol = (hl < 4 ? GR + hl * 128 : RG + (hl - 4) * 128) + seg * 16;
        const bf16_t* gp = proj + (R0 + row) * LD + gcol; const u32x4 g0 = *(const u32x4*)gp, g1 = *(const u32x4*)(gp + 8);
        float gt[16] = {bflo(g0.x), bfhi(g0.x), bflo(g0.y), bfhi(g0.y), bflo(g0.z), bfhi(g0.z), bflo(g0.w), bfhi(g0.w), bflo(g1.x), bfhi(g1.x), bflo(g1.y), bfhi(g1.y), bflo(g1.z), bfhi(g1.z), bflo(g1.w), bfhi(g1.w)};
        const float* hg = a.head_gain + (size_t)L * D + 1024 + hl * 128 + seg * 16;
        float res[16];
#pragma unroll
        for (int e = 0; e < 16; ++e) res[e] = ov[e] * rs * hg[e] * siluf(gt[e]);
        bf16_t* mp = (bf16_t*)(a.ws + WS_MRG) + (R0 + row) * D + 1024 + hl * 128 + seg * 16;
        u32x4 w0, w1; w0.x = cvt_pk_bf16(res[0], res[1]); w0.y = cvt_pk_bf16(res[2], res[3]); w0.z = cvt_pk_bf16(res[4], res[5]); w0.w = cvt_pk_bf16(res[6], res[7]);
        w1.x = cvt_pk_bf16(res[8], res[9]); w1.y = cvt_pk_bf16(res[10], res[11]); w1.z = cvt_pk_bf16(res[12], res[13]); w1.w = cvt_pk_bf16(res[14], res[15]);
        *(u32x4*)mp = w0; *(u32x4*)(mp + 8) = w1; }
}
}

__device__ __forceinline__ void unpack8(const u32x4 w, float (&v)[8]) { v[0] = bflo(w.x); v[1] = bfhi(w.x); v[2] = bflo(w.y); v[3] = bfhi(w.y); v[4] = bflo(w.z); v[5] = bfhi(w.z); v[6] = bflo(w.w); v[7] = bfhi(w.w); }
__device__ __forceinline__ void conv_fix_panel(const Args& a, int L, int pm) {
    const float* HB = (const float*)(a.ws + WS_U); bf16_t* act = (bf16_t*)(a.ws + WS_ACT);
    const float* cw = a.conv_w + (size_t)L * 3 * UPW;
    const int tid = otid(); constexpr int NTN = UPW / 256;
    for (int idx = tid; idx < 2 * DFF; idx += NTHR) {
        const int side = idx >= DFF ? 1 : 0, ch = idx - side * DFF, pn = ch >> 7, lc = ch & 127, tile = pm * NTN + pn;
        const float* hb = HB + (size_t)tile * 1024;
        float pa = hb[(2 + side) * 256 + lc], pg = hb[(2 + side) * 256 + 128 + lc];
        if (side == 0 && (pm & 15) != 0) { const float* nb = HB + (size_t)(tile - NTN) * 1024 + 256; pa += cw[ch] * nb[lc]; pg += cw[DFF + ch] * nb[128 + lc]; }
        if (side == 1 && (pm & 15) != 15) { const float* nb = HB + (size_t)(tile + NTN) * 1024; pa += cw[2 * UPW + ch] * nb[lc]; pg += cw[2 * UPW + DFF + ch] * nb[128 + lc]; }
        act[(size_t)(pm * 256 + (side ? 255 : 0)) * DFF + ch] = (bf16_t)f2bf(pa * siluf(pg));
    }
}

__device__ __forceinline__ void final_phase(const Args& a) {
    const int tid = otid(); const int lane = tid & 63, gw = blockIdx.x * NWAVE + (tid >> 6), NGW = gridDim.x * NWAVE;
    const u64_t* ss = (const u64_t*)(a.ws + WS_SS) + 8 * M;
    for (int m = gw; m < M; m += NGW) { const float rs = ss_rstd(ss, m); f32x4* xr = (f32x4*)(a.out + (size_t)m * D) + lane; const f32x4* gp = (const f32x4*)a.final_g + lane;
#pragma unroll
        for (int j = 0; j < 8; ++j) { const f32x4 v = xr[64 * j]; xr[64 * j] = v * rs * gp[64 * j]; } }
}


__device__ __forceinline__ void inproj_strip(const bf16_t* __restrict__ xb, const bf16_t* __restrict__ wt, const u64_t* ss, bf16_t* proj, int G, int bx, LAS unsigned char* lds) {
    const int tid = otid(), wid = tid >> 6, lane = tid & 63, r32 = lane & 31, hi = lane >> 5;
    LAS float* red = (LAS float*)lds;
    for (int rb = bx; rb < M / 32; rb += G) {
        const bf16_t* ap = xb + (size_t)(rb * 32 + r32) * D + wid * 256 + hi * 8;
        const bf16_t* bp = wt + (size_t)(GAF + r32) * D + wid * 256 + hi * 8;
        f32x16 acc = f32x16{};
#pragma unroll
        for (int ks = 0; ks < 16; ++ks) { const bf16x8 av = *(const bf16x8*)(ap + ks * 16), bv = *(const bf16x8*)(bp + ks * 16);
            acc = __builtin_amdgcn_mfma_f32_32x32x16_bf16(av, bv, acc, 0, 0, 0); }
        __syncthreads();
#pragma unroll
        for (int r = 0; r < 16; ++r) red[(wid * 32 + ((r & 3) + 8 * (r >> 2) + 4 * hi)) * 33 + r32] = acc[r];
        __syncthreads();
        for (int o = tid; o < 1024; o += NTHR) { const int row = o >> 5, col = o & 31; float v = 0.f;
#pragma unroll
            for (int w = 0; w < 8; ++w) v += red[(w * 32 + row) * 33 + col];
            proj[(size_t)(rb * 32 + row) * INP + GAF + col] = (bf16_t)f2bf(v * ss_rstd(ss, rb * 32 + row)); }
    }
    __syncthreads();
}

#define XB_TMO      128
#define XB_XCNT(j)  (256  + 64 * (j))
#define XB_XSUB(j)  (1280 + 64 * (j))
#define XB_XGEN(j)  (2304 + 64 * (j))
#define XB_TOP      3328
#define XB_TOPGEN   3392
#define XCD_BAR_WORDS 3456
#define XB_SPIN_CAP (1u << 18)
__device__ __forceinline__ unsigned xb_ld(unsigned* p)              { return __hip_atomic_load(p, __ATOMIC_RELAXED, __HIP_MEMORY_SCOPE_AGENT); }
__device__ __forceinline__ unsigned xb_add(unsigned* p, unsigned v) { return __hip_atomic_fetch_add(p, v, __ATOMIC_RELAXED, __HIP_MEMORY_SCOPE_AGENT); }
__device__ __forceinline__ unsigned xb_xcc_id() { return (unsigned)__builtin_amdgcn_s_getreg((3 << 11) | 20) & 0xFu; }
#define XB_SPIN(cond, bar) do { unsigned _sp = 0; while (cond) { __builtin_amdgcn_s_sleep(1); \
    if ((++_sp & 255u) == 0u) { if (xb_ld(&(bar)[XB_TMO])) break; if (_sp > XB_SPIN_CAP) { atomicAdd(&(bar)[XB_TMO], 1u); break; } } } } while (0)
struct XcdBarrier { unsigned* bar; unsigned x; volatile LAS unsigned* st; };
__device__ __forceinline__ XcdBarrier xcd_barrier_post(unsigned* bar, volatile LAS unsigned* st) {
    XcdBarrier b; b.bar = bar; b.x = xb_xcc_id(); b.st = st;
    if (threadIdx.x == 0) (void)xb_add(&bar[XB_XCNT(b.x)], 1u);
    return b;
}
__device__ __forceinline__ void xcd_barrier_complete(unsigned* bar, unsigned x, unsigned& nloc, unsigned& nx) {
    const unsigned G = gridDim.x * gridDim.y * gridDim.z;
    unsigned sum, cnt, mine, sp = 0u;
    for (;;) {
        sum = 0u; cnt = 0u; mine = 0u;
#pragma unroll
        for (unsigned j = 0; j < 16; ++j) { const unsigned c = xb_ld(&bar[XB_XCNT(j)]); sum += c; cnt += (c > 0u) ? 1u : 0u; mine = (j == x) ? c : mine; }
        if (sum == G) break;
        __builtin_amdgcn_s_sleep(1);
        if ((++sp & 255u) == 0u) { if (xb_ld(&bar[XB_TMO])) break; if (sp > XB_SPIN_CAP) { atomicAdd(&bar[XB_TMO], 1u); break; } }
    }
    nloc = mine > 0u ? mine : 1u; nx = cnt > 0u ? cnt : 1u;
}
__device__ __forceinline__ void xcd_barrier(const XcdBarrier& b) {
    asm volatile("s_waitcnt vmcnt(0)" ::: "memory");
    __syncthreads();
    if (threadIdx.x == 0) {
        unsigned* bar = b.bar;
        __builtin_amdgcn_s_waitcnt(0);
        unsigned nloc = b.st[0], nx = b.st[1];
        if (nloc == 0u) { xcd_barrier_complete(bar, b.x, nloc, nx); b.st[0] = nloc; b.st[1] = nx; }
        const unsigned old = xb_add(&bar[XB_XSUB(b.x)], 1u);
        const unsigned gen = old / nloc;
        if (old + 1u == (gen + 1u) * nloc) {
            __builtin_amdgcn_fence(__ATOMIC_RELEASE, "agent");
            asm volatile("s_waitcnt vmcnt(0)" ::: "memory");
            const unsigned og = xb_add(&bar[XB_TOP], 1u);
            const unsigned tg = og / nx;
            if (og + 1u == (tg + 1u) * nx) xb_add(&bar[XB_TOPGEN], 1u);
            else XB_SPIN(xb_ld(&bar[XB_TOPGEN]) == tg, bar);
            __builtin_amdgcn_fence(__ATOMIC_ACQUIRE, "agent");
            xb_add(&bar[XB_XGEN(b.x)], 1u);
            asm volatile("s_waitcnt vmcnt(0)" ::: "memory");
        } else {
            XB_SPIN(xb_ld(&bar[XB_XGEN(b.x)]) == gen, bar);
            __builtin_amdgcn_fence(__ATOMIC_ACQUIRE, "agent");
            asm volatile("s_waitcnt vmcnt(0)" ::: "memory");
        }
    }
    __syncthreads();
}

constexpr int N_PHASES = 2 + 8 * DEPTH;
#ifndef GEMM_ALIGN
#define GEMM_ALIGN true
#endif
__global__ void __launch_bounds__(NTHR, 2) mega_fwd(Args a0) {
    extern __shared__ __attribute__((aligned(16))) unsigned char lds_raw[];
    LAS unsigned char* lds = (LAS unsigned char*)lds_raw;
    volatile LAS unsigned* MISC = (volatile LAS unsigned*)(lds + 131072);
    if (threadIdx.x < 32) MISC[threadIdx.x] = 0u;
    if (threadIdx.x < 256) ((LAS float*)(lds + 131072 + 256))[8 * 256 + threadIdx.x] = 0.f;
    __syncthreads();
    XcdBarrier gbar; gbar.bar = (unsigned*)(a0.ws + WS_BAR); gbar.x = 0; gbar.st = MISC + 8;
    if (a0.ph_hi - a0.ph_lo > 1) gbar = xcd_barrier_post((unsigned*)(a0.ws + WS_BAR), MISC + 8);
    bool first_sync = true;
#define GRID_SYNC() do { if (first_sync) { cg::this_grid().sync(); first_sync = false; } else xcd_barrier(gbar); } while (0)
    for (int ph = a0.ph_lo; ph < a0.ph_hi; ++ph) {
      int G = gridDim.x, bx = blockIdx.x; asm volatile("" : "+s"(G), "+s"(bx));
      const int vcu = (G % 8 == 0) ? (bx % 8) * (G / 8) + bx / 8 : bx;
      Args a = a0; asm volatile("" : "+s"(a.ws), "+s"(a.out), "+s"(a.x), "+s"(a.ln1_g), "+s"(a.w_in), "+s"(a.diff_lambda), "+s"(a.rel_bias), "+s"(a.gate_w), "+s"(a.gate_b), "+s"(a.decay_logit), "+s"(a.head_gain), "+s"(a.w_o), "+s"(a.ln2_g), "+s"(a.w_up), "+s"(a.conv_w), "+s"(a.conv_b), "+s"(a.w_down), "+s"(a.final_g));
      u64_t* ssb = (u64_t*)(a.ws + WS_SS);
      bf16_t* xb = (bf16_t*)(a.ws + WS_XB); bf16_t* proj = (bf16_t*)(a.ws + WS_PROJ); bf16_t* mrg = (bf16_t*)(a.ws + WS_MRG); bf16_t* actb = (bf16_t*)(a.ws + WS_ACT);
      const int sub_ = (ph == 0) ? 100 : (ph == N_PHASES - 1 ? 101 : ((ph - 1) & 7));
      const int nrep = (PROBE_SUB >= 0 && (sub_ == PROBE_SUB || (sub_ == 1 && (PROBE_SUB == 11 || PROBE_SUB == 12)))) ? 2 : 1;
      if (sub_ == 6) continue;
      for (int rep = 0; rep < nrep; ++rep) {
        if (rep) GRID_SYNC();
        if (ph == 0) {
#ifndef NO_PRO
 phase_prologue(a, lds);
#endif
 }
        else if (ph == N_PHASES - 1) { final_phase(a); }
        else {
            const int L = (ph - 1) >> 3, sub = (ph - 1) & 7;
            const unsigned char* wl = a.ws + WS_W + (size_t)L * W_LAYER;
            if (sub == 0) {
                inproj_strip(xb, (const bf16_t*)(wl + W_IN), ssb + (2 * L) * M, proj, G, bx, lds);
                pg8::Gemm g{xb, (const bf16_t*)(wl + W_IN), M, NGEMM_IN, D}; pg8::StaticOrder S; S.init(M, NGEMM_IN, G, bx);
                pg8::EpiScaleBf16 E{proj, INP, ssb + (2 * L) * M};
#if !defined(NO_GEMM) && !defined(NO_GEMM_A)
                pg8::gemm_phase<pg8::EpiScaleBf16, pg8::StaticOrder, GEMM_ALIGN, true>(lds, g, S, E);
#endif
            } else if (sub == 5) {
                pg8::Gemm g{xb, (const bf16_t*)(wl + W_UP), M, UPW, D}; pg8::StaticOrder S; S.init(M, UPW, G, bx);
                pg8::EpiConvGate E{actb, ssb + (2 * L + 1) * M, a.conv_w + (size_t)L * 3 * UPW, a.conv_b + (size_t)L * UPW, (float*)(a.ws + WS_U), (LAS float*)(lds + 131072 + 256)};
#if !defined(NO_GEMM) && !defined(NO_GEMM_C)
                pg8::gemm_phase<pg8::EpiConvGate, pg8::StaticOrder, true, true>(lds, g, S, E);
#endif
            } else if (sub == 4 || sub == 7) {
                const bool dn = sub == 7;
                pg8::Gemm g{dn ? actb : mrg, (const bf16_t*)(wl + (dn ? W_DN : W_O)), M, D, dn ? DFF : D}; pg8::StaticOrder S; S.init(M, D, G, bx);
                if (dn) { pg8::Unit fu; for (int i = 0; S.next(i, fu); ++i) conv_fix_panel(a, L, fu.pm);
                    asm volatile("s_waitcnt vmcnt(0)" ::: "memory"); __syncthreads(); }
                pg8::EpiResid E{a.out, xb, ssb + (2 * L + (dn ? 2 : 1)) * M};
#if !defined(NO_GEMM) && !defined(NO_GEMM_B)
                pg8::gemm_phase<pg8::EpiResid, pg8::StaticOrder, GEMM_ALIGN, true>(lds, g, S, E);
#endif
            } else if (sub == 1) {
#ifndef NO_R1
                if (!(rep && PROBE_SUB == 12)) for (int it = vcu; it < 1024; it += G) lin::r1_item(a, L, it, lds);
#endif
#ifndef NO_ATT
                const float lam = ((const float*)(a.ws + WS_LAM))[L]; const float li = 0.8f - 0.6f * __expf(-0.3f * (float)L);
                if (!(rep && PROBE_SUB == 11)) for (int u = vcu; u < 256; u += G)
                    att::attn_unit(u >> 7, (u >> 4) & 7, u & 15, proj, (const float*)(a.ws + WS_BTAB), lam, 1.0f - li, a.head_gain + (size_t)L * D,
                                   (float*)(a.ws + WS_O1) + (size_t)bx * 64 * NTHR, mrg, (LAS char*)lds);
#endif
            } else if (sub == 2) {
#ifndef NO_SCAN
                lin::scan_phase(a);
#endif
            } else if (sub == 3) {
#ifndef NO_R3
                for (int it = vcu; it < 1024; it += G) lin::r3_item(a, L, it, lds);
#endif
            }
        }
      }
        if (ph + 1 < a0.ph_hi) GRID_SYNC();
    }
}

extern "C" void kernel_launch(void* const* d_in, const int* in_sizes, int n_in, void* d_out, int out_size, void* d_ws, size_t ws_size, hipStream_t stream) {
    static int grid = 0;
    if (grid == 0) {
        if (n_in != 16 || in_sizes[0] != M * D || out_size != M * D || ws_size < WS_END) {
            fprintf(stderr, "kernel_launch: unexpected shapes (n_in %d in0 %d out %d ws %zu need %zu)\n", n_in, n_in > 0 ? in_sizes[0] : -1, out_size, ws_size, (size_t)WS_END); grid = -1; return; }
        int dev = 0, cus = 0, per_cu = 0;
        hipGetDevice(&dev); hipDeviceGetAttribute(&cus, hipDeviceAttributeMultiprocessorCount, dev);
        if (hipFuncSetAttribute((const void*)mega_fwd, hipFuncAttributeMaxDynamicSharedMemorySize, LDS_BYTES) != hipSuccess) { fprintf(stderr, "kernel_launch: hipFuncSetAttribute failed\n"); grid = -1; return; }
        if (hipOccupancyMaxActiveBlocksPerMultiprocessor(&per_cu, (const void*)mega_fwd, NTHR, LDS_BYTES) != hipSuccess || per_cu < 1) { fprintf(stderr, "kernel_launch: occupancy query says %d\n", per_cu); per_cu = 1; }
        (void)hipGetLastError();
        grid = cus * 1;
        fprintf(stderr, "kernel_launch: grid %d (cus %d, per_cu %d)\n", grid, cus, per_cu);
    }
    if (grid < 0) return;
    hipMemsetAsync((char*)d_ws + WS_SS, 0, SS_BYTES, stream);
    Args a{};
    a.x = (const float*)d_in[0]; a.ln1_g = (const float*)d_in[1]; a.w_in = (const float*)d_in[2]; a.diff_lambda = (const float*)d_in[3]; a.rel_bias = (const float*)d_in[4];
    a.gate_w = (const float*)d_in[5]; a.gate_b = (const float*)d_in[6]; a.decay_logit = (const float*)d_in[7]; a.head_gain = (const float*)d_in[8]; a.w_o = (const float*)d_in[9];
    a.ln2_g = (const float*)d_in[10]; a.w_up = (const float*)d_in[11]; a.conv_w = (const float*)d_in[12]; a.conv_b = (const float*)d_in[13]; a.w_down = (const float*)d_in[14];
    a.final_g = (const float*)d_in[15]; a.out = (float*)d_out; a.ws = (unsigned char*)d_ws;
#if MK_MULTI
    for (int ph = 0; ph < N_PHASES; ++ph) { a.ph_lo = ph; a.ph_hi = ph + 1; hipLaunchKernelGGL(mega_fwd, dim3(grid), dim3(NTHR), LDS_BYTES, stream, a); }
#else
    a.ph_lo = 0; a.ph_hi = N_PHASES;
    void* args[] = {&a};
    hipError_t e = hipLaunchCooperativeKernel((const void*)mega_fwd, dim3(grid), dim3(NTHR), args, LDS_BYTES, stream);
    if (e != hipSuccess) fprintf(stderr, "kernel_launch: cooperative launch failed: %s (grid %d)\n", hipGetErrorString(e), grid);
#endif
}
```

```cpp
#include <hip/hip_runtime.h>
#include <hip/hip_cooperative_groups.h>
#include <cstdio>
#include <cstdint>
namespace cg = cooperative_groups;

#ifndef MK_MULTI
#define MK_MULTI 0
#endif

#ifndef PROBE_SUB
#define PROBE_SUB -1
#endif
#define LAS __attribute__((address_space(3)))
typedef unsigned short bf16_t;
typedef short bf16x8 __attribute__((ext_vector_type(8)));
typedef short s16x4 __attribute__((ext_vector_type(4)));
typedef float f32x2 __attribute__((ext_vector_type(2)));
typedef float f32x4 __attribute__((ext_vector_type(4)));
typedef float f32x16 __attribute__((ext_vector_type(16)));
typedef unsigned u32x2 __attribute__((ext_vector_type(2)));
typedef unsigned u32x4 __attribute__((ext_vector_type(4)));

constexpr int NB = 2, T = 4096, M = NB * T, D = 2048, INW = 6176, INP = 6400, DFF = 5632, UPW = 2 * DFF, DEPTH = 4;
constexpr int OQ = 0, OKK = 1024, OV = 2048, GQ = 3072, GK = 3328, GV = 3584, GR = 4096, RQ = 4608, RK = 4864, RV = 5120, RG = 5632, GAF = 6144, GAB = 6160, NGEMM_IN = 6144;
constexpr int SRC_GA = 4608, SRC_RK = 4896, SRC_RV = 5152;
constexpr float EPS = 1e-6f;
constexpr int NTHR = 512, NWAVE = 8;
constexpr int BTAB_N = 448, BTAB_OFF = 224;

constexpr size_t MiB = 1u << 20;
constexpr size_t WS_SS = 0;
constexpr size_t SS_BYTES = 1 * MiB;
constexpr size_t WS_BAR = 768 * 1024;
constexpr size_t WS_LAM = 1 * MiB;
constexpr size_t WS_BTAB = 1 * MiB + 4096;
constexpr size_t WS_ROPE = 2 * MiB;
constexpr size_t WS_W = 3 * MiB;
constexpr size_t W_IN = 0, W_O = 25 * MiB, W_UP = 33 * MiB, W_DN = 77 * MiB, W_LAYER = 99 * MiB;
constexpr size_t WS_XB = WS_W + 4 * W_LAYER;
constexpr size_t WS_PROJ = WS_XB + 32 * MiB;
constexpr size_t WS_MRG = WS_PROJ + 100 * MiB;
constexpr size_t WS_U = WS_MRG + 32 * MiB;
constexpr size_t WS_ACT = WS_U + 176 * MiB;
constexpr size_t WS_KVT = WS_ACT + 88 * MiB;
constexpr size_t WS_ST = WS_KVT + 64 * MiB;
constexpr size_t WS_DEC = WS_ST + 32 * MiB;
constexpr size_t WS_O1 = WS_DEC + 1 * MiB;
constexpr size_t WS_END = WS_O1 + 32 * MiB;

constexpr int LDS_BYTES = 131072 + 256 + 11 * 1024 + 512 * 16 + 4096;

__device__ __forceinline__ unsigned cvt_pk_bf16(float lo, float hi) { unsigned r; asm volatile("v_cvt_pk_bf16_f32 %0, %1, %2" : "=v"(r) : "v"(lo), "v"(hi)); return r; }
__device__ __forceinline__ unsigned f2bf(float f) { unsigned u = __builtin_bit_cast(unsigned, f); return (u + 0x7fffu + ((u >> 16) & 1u)) >> 16; }
__device__ __forceinline__ float bf2f(unsigned short h) { return __builtin_bit_cast(float, (unsigned)h << 16); }
__device__ __forceinline__ float bflo(unsigned w) { return __builtin_bit_cast(float, w << 16); }
__device__ __forceinline__ float bfhi(unsigned w) { return __builtin_bit_cast(float, w & 0xffff0000u); }
__device__ __forceinline__ float logsigmoidf(float x) { return fminf(x, 0.f) - __logf(1.f + __expf(-fabsf(x))); }
__device__ __forceinline__ float siluf(float x) { return x * __builtin_amdgcn_rcpf(1.f + __expf(-x)); }
__device__ __forceinline__ float wave_sum(float v) {
#pragma unroll
    for (int o = 1; o < 64; o <<= 1) v += __shfl_xor(v, o);
    return v;
}
#define LDS_WAIT() asm volatile("s_waitcnt lgkmcnt(0)" ::: "memory")
typedef unsigned long long u64_t;
constexpr float SS_FX = 16777216.0f, SS_IFX = 1.0f / 16777216.0f;
__device__ __forceinline__ float ss_rstd(const u64_t* ss, int row) { return __builtin_amdgcn_rsqf((float)ss[row] * (SS_IFX / (float)2048) + 1e-6f); }
__device__ __forceinline__ int otid() { int t = threadIdx.x; asm volatile("" : "+v"(t)); return t; }

namespace pg8 {
constexpr int BM = 256, BK = 64, HALF = 128, HTB = HALF * BK * 2, STAGE_BYTES = 8 * HTB, NXCD = 8, WGM = 4;
__host__ __device__ __forceinline__ int lds_byte(int r, int c) { const int st = (r >> 4) * 2 + (c >> 5), rr = r & 15, cc = c & 31, ob = rr * 64 + cc * 2; return st * 1024 + (ob ^ (((ob >> 9) & 1) << 5)); }
__host__ __device__ __forceinline__ void stage_rc(int b, int& R, int& C) { const int st = b / 1024, sb = b % 1024, swz = sb ^ (((sb >> 9) & 1) << 5); R = (st >> 1) * 16 + swz / 64; C = (st & 1) * 32 + (swz % 64) / 2; }
__host__ __device__ __forceinline__ int perm32(int rho) { const int n = rho >> 4, i = rho & 15; return 8 * (i >> 2) + 4 * n + (i & 3); }
struct Unit { int pm, pn; };
struct Gemm { const bf16_t* A; const bf16_t* Bt; int M, N, K; };
struct StaticOrder {
    int nM, nN, nwg, G, c;
    __host__ __device__ void init(int M_, int N_, int G_, int c_) { nM = M_ / BM; nN = N_ / BM; nwg = nM * nN; G = G_; c = c_; }
    __host__ __device__ bool next(int i, Unit& u) const {
        const long L = (long)i * G + c; if (L >= nwg) return false;
        int wgid = (int)L; { const int q = nwg / NXCD, r = nwg % NXCD, xcd = wgid % NXCD, off = wgid / NXCD; wgid = (xcd < r ? xcd * (q + 1) : r * (q + 1) + (xcd - r) * q) + off; }
        const int nig = WGM * nN, gid = wgid / nig, fm = gid * WGM, gsz = (nM - fm) < WGM ? (nM - fm) : WGM;
        u.pm = fm + ((wgid % nig) % gsz); u.pn = (wgid % nig) / gsz; return true;
    }
    __device__ __forceinline__ void a_ready(const Unit&) const {}
    __device__ __forceinline__ void done(const Unit&) const {}
};

struct EpiScaleBf16 {
    static constexpr bool PERM = true, AFTER_DRAIN = false;
    bf16_t* O; int ldc; const u64_t* ss;
    __device__ __forceinline__ void operator()(const f32x4 (&acc)[2][2][4][2], const Unit& u, int wr, int wc, int fr, int fq) const {
        const int row0 = u.pm * BM + wr * 64 + fr, col0 = u.pn * BM + wc * 32 + 8 * fq;
#pragma unroll
        for (int ai = 0; ai < 2; ++ai)
#pragma unroll
            for (int m = 0; m < 4; ++m) {
                const int row = row0 + ai * HALF + m * 16;
                const float sc = ss_rstd(ss, row);
                bf16_t* rowp = O + (size_t)row * ldc + col0;
#pragma unroll
                for (int bj = 0; bj < 2; ++bj) { const f32x4 v0 = acc[ai][bj][m][0] * sc, v1 = acc[ai][bj][m][1] * sc;
                    u32x4 w; w.x = cvt_pk_bf16(v0[0], v0[1]); w.y = cvt_pk_bf16(v0[2], v0[3]); w.z = cvt_pk_bf16(v1[0], v1[1]); w.w = cvt_pk_bf16(v1[2], v1[3]);
                    *(u32x4*)(rowp + bj * HALF) = w; }
                asm volatile("" ::: "memory");
            }
    }
};

#define DPPF(old, src, ctrl) __builtin_bit_cast(float, __builtin_amdgcn_update_dpp(__builtin_bit_cast(int, (float)(old)), __builtin_bit_cast(int, (float)(src)), (ctrl), 0xf, 0xf, false))
__device__ __forceinline__ f32x4 dpp4_shr1(f32x4 o, f32x4 v) { return (f32x4){DPPF(o[0], v[0], 0x111), DPPF(o[1], v[1], 0x111), DPPF(o[2], v[2], 0x111), DPPF(o[3], v[3], 0x111)}; }
__device__ __forceinline__ f32x4 dpp4_shl1(f32x4 o, f32x4 v) { return (f32x4){DPPF(o[0], v[0], 0x101), DPPF(o[1], v[1], 0x101), DPPF(o[2], v[2], 0x101), DPPF(o[3], v[3], 0x101)}; }
__device__ __forceinline__ f32x4 dpp4_ror1(f32x4 v) { return (f32x4){DPPF(v[0], v[0], 0x121), DPPF(v[1], v[1], 0x121), DPPF(v[2], v[2], 0x121), DPPF(v[3], v[3], 0x121)}; }
__device__ __forceinline__ f32x4 dpp4_ror15(f32x4 v) { return (f32x4){DPPF(v[0], v[0], 0x12f), DPPF(v[1], v[1], 0x12f), DPPF(v[2], v[2], 0x12f), DPPF(v[3], v[3], 0x12f)}; }
struct EpiConvGate {
    static constexpr bool PERM = true, AFTER_DRAIN = false;
    bf16_t* ACT; const u64_t* ss; const float* cw; const float* cb; float* HB; LAS float* HL;
    __device__ __forceinline__ void operator()(f32x4 (&acc)[2][2][4][2], const Unit& u, int wr, int wc, int fr_in, int fq_in) const {
        int fr = fr_in, fq = fq_in; asm volatile("" : "+v"(fr), "+v"(fq));
        const int wv = wr * 4 + wc;
        LAS float* PAL = HL + 9 * 256; LAS float* DMP = HL + 11 * 256 + (wv * 64 + fq * 16 + fr) * 4; LAS float* WL = HL + 11 * 256 + 512 * 4;
        if (wv < 4) { const int cl = wv * 64 + fq * 16 + fr, ch = ((cl >> 7) ? DFF : 0) + u.pn * 128 + (cl & 127);
            WL[cl] = cw[ch]; WL[256 + cl] = cw[UPW + ch]; WL[512 + cl] = cw[2 * UPW + ch]; WL[768 + cl] = cb[ch]; }
#pragma unroll
        for (int ai = 0; ai < 2; ++ai)
#pragma unroll
            for (int m = 0; m < 4; ++m) { asm volatile("" : "+v"(fr)); const float sc = ss_rstd(ss, u.pm * BM + ai * HALF + wr * 64 + m * 16 + fr);
#pragma unroll
                for (int bj = 0; bj < 2; ++bj)
#pragma unroll
                    for (int n = 0; n < 2; ++n) acc[ai][bj][m][n] *= sc; }
        float* hb = HB + (size_t)(u.pm * (UPW / 256) + u.pn) * 1024;
#pragma unroll
        for (int ai = 0; ai < 2; ++ai) { const int blk = 2 * ai + wr;
            asm volatile("" : "+v"(fr), "+v"(fq)); const int lc0 = wc * 32 + 8 * fq;
#pragma unroll
            for (int bj = 0; bj < 2; ++bj)
#pragma unroll
                for (int n = 0; n < 2; ++n) {
                    LAS float* d0 = fr == 0 ? HL + (blk * 2 + 0) * 256 + bj * 128 + lc0 + 4 * n : DMP;
                    LAS float* d1 = fr == 15 ? HL + (blk * 2 + 1) * 256 + bj * 128 + lc0 + 4 * n : DMP;
                    *(LAS f32x4*)d0 = acc[ai][bj][0][n]; *(LAS f32x4*)d1 = acc[ai][bj][3][n]; }
        }
        asm volatile("s_waitcnt lgkmcnt(0)" ::: "memory"); __builtin_amdgcn_s_barrier(); asm volatile("" ::: "memory");
        if (wv == 0) { const int l4 = (fq * 16 + fr) * 4;
            *(f32x4*)(hb + l4) = *(const LAS f32x4*)(HL + l4); *(f32x4*)(hb + 256 + l4) = *(const LAS f32x4*)(HL + 7 * 256 + l4); }
#pragma unroll
        for (int ai = 0; ai < 2; ++ai) { const int blk = 2 * ai + wr;
            const int upslot = blk > 0 ? (blk - 1) * 2 + 1 : 8, dnslot = blk < 3 ? (blk + 1) * 2 : 8;
#pragma unroll
            for (int q = 0; q < 4; ++q) { const int bj = q >> 1, n = q & 1;
                asm volatile("" : "+v"(fr), "+v"(fq)); const int lc0 = wc * 32 + 8 * fq;
                const int cl = bj * 128 + lc0 + 4 * n;
                const f32x4 w0 = *(const LAS f32x4*)(WL + cl), w1 = *(const LAS f32x4*)(WL + 256 + cl), w2 = *(const LAS f32x4*)(WL + 512 + cl), bb = *(const LAS f32x4*)(WL + 768 + cl);
                f32x4 carry = *(const LAS f32x4*)(HL + upslot * 256 + bj * 128 + lc0 + 4 * n);
                const f32x4 hdn = *(const LAS f32x4*)(HL + dnslot * 256 + bj * 128 + lc0 + 4 * n);
#pragma unroll
                for (int m = 0; m < 4; ++m) { const f32x4 cur = acc[ai][bj][m][n];
                    const f32x4 up = dpp4_shr1(carry, cur);
                    const f32x4 nf = m < 3 ? dpp4_ror15(acc[ai][bj][m < 3 ? m + 1 : 3][n]) : hdn;
                    const f32x4 dn = dpp4_shl1(nf, cur);
                    carry = dpp4_ror1(cur);
                    acc[ai][bj][m][n] = w0 * up + w1 * cur + w2 * dn + bb; }
                if (ai == 0) { LAS float* d0 = ((wr == 0) & (fr == 0)) ? PAL + bj * 128 + lc0 + 4 * n : DMP; *(LAS f32x4*)d0 = acc[ai][bj][0][n]; }
                if (ai == 1) { LAS float* d1 = ((wr == 1) & (fr == 15)) ? PAL + 256 + bj * 128 + lc0 + 4 * n : DMP; *(LAS f32x4*)d1 = acc[ai][bj][3][n]; }
                asm volatile("s_waitcnt lgkmcnt(0)" ::: "memory");
            }
            asm volatile("" : "+v"(fr), "+v"(fq));
#pragma unroll
            for (int m = 0; m < 4; ++m) { const int row = u.pm * BM + ai * HALF + wr * 64 + m * 16 + fr;
                const f32x4 a0 = acc[ai][0][m][0], a1 = acc[ai][0][m][1], g0 = acc[ai][1][m][0], g1 = acc[ai][1][m][1];
                u32x4 w; w.x = cvt_pk_bf16(a0[0] * siluf(g0[0]), a0[1] * siluf(g0[1])); w.y = cvt_pk_bf16(a0[2] * siluf(g0[2]), a0[3] * siluf(g0[3]));
                w.z = cvt_pk_bf16(a1[0] * siluf(g1[0]), a1[1] * siluf(g1[1])); w.w = cvt_pk_bf16(a1[2] * siluf(g1[2]), a1[3] * siluf(g1[3]));
                *(u32x4*)(ACT + (size_t)row * DFF + u.pn * 128 + wc * 32 + 8 * fq) = w;
                asm volatile("" ::: "memory"); }
        }
        asm volatile("s_waitcnt lgkmcnt(0)" ::: "memory"); __builtin_amdgcn_s_barrier(); asm volatile("" ::: "memory");
        if (wv == 0) { const int l4 = (fq * 16 + fr) * 4;
            *(f32x4*)(hb + 512 + l4) = *(const LAS f32x4*)(PAL + l4); *(f32x4*)(hb + 768 + l4) = *(const LAS f32x4*)(PAL + 256 + l4);
            asm volatile("s_waitcnt lgkmcnt(0)" ::: "memory"); }
    }
};
struct EpiResid {
    static constexpr bool PERM = false, AFTER_DRAIN = false;
    float* X; bf16_t* XB; u64_t* ssn;
    __device__ __forceinline__ void operator()(const f32x4 (&acc)[2][2][4][2], const Unit& u, int wr, int wc, int fr, int fq) const {
        const int col0 = u.pn * BM + wc * 32 + 4 * fq;
#pragma unroll
        for (int ai = 0; ai < 2; ++ai)
#pragma unroll
            for (int m = 0; m < 4; ++m) {
                const int row = u.pm * BM + ai * HALF + wr * 64 + m * 16 + fr; const size_t off = (size_t)row * D + col0; float part = 0.f;
#pragma unroll
                for (int bj = 0; bj < 2; ++bj)
#pragma unroll
                    for (int n = 0; n < 2; ++n) { float* xp = X + off + bj * HALF + n * 16; const f32x4 xv = *(const f32x4*)xp + acc[ai][bj][m][n]; *(f32x4*)xp = xv;
                        part += (xv[0] * xv[0] + xv[1] * xv[1]) + (xv[2] * xv[2] + xv[3] * xv[3]);
                        u32x2 w; w.x = cvt_pk_bf16(xv[0], xv[1]); w.y = cvt_pk_bf16(xv[2], xv[3]); *(u32x2*)(XB + off + bj * HALF + n * 16) = w; }
                part += __shfl_xor(part, 16); part += __shfl_xor(part, 32);
                if (fq == 0) atomicAdd(ssn + row, (u64_t)(part * SS_FX + 0.5f));
                asm volatile("" ::: "memory");
            }
    }
};

template <class Epi, class Sched, bool ALIGN_EPI = false, bool SP2 = false>
__device__ __forceinline__ void gemm_phase(LAS unsigned char* lds, const Gemm g, const Sched& S, const Epi& E) {
    const int tid = otid(), wid = __builtin_amdgcn_readfirstlane(tid >> 6), lane = tid & 63, wr = wid >> 2, wc = wid & 3, fr = lane & 15, fq = lane >> 4;
    const int K = g.K, nt = K / BK;
    unsigned voffA[2], voffB[2];
#pragma unroll
    for (int i = 0; i < 2; ++i) { int R, C; stage_rc(tid * 16 + i * 8192, R, C); const int Rb = Epi::PERM ? ((R & ~31) + perm32(R & 31)) : R;
        voffA[i] = (unsigned)(R * K + C) * 2u; voffB[i] = (unsigned)(Rb * K + C) * 2u; }
    const size_t kstep = (size_t)(BK * 2);
    const size_t hstep = (size_t)HALF * K * 2;
    const size_t tstep = 2 * hstep;
    const unsigned ldsw = (unsigned)wid * 1024u;
    const int aoff = lds_byte(wr * 64 + fr, fq * 8), boff = lds_byte(wc * 32 + fr, fq * 8);
#define PG8_SA(b, h) (((b) * 2 + (h)) * HTB)
#define PG8_SB(b, h) ((4 + (b) * 2 + (h)) * HTB)
#define PG8_STAGE(bufoff, gbase, voff) do { _Pragma("unroll") for (int _i = 0; _i < 2; ++_i) \
        __builtin_amdgcn_global_load_lds((const unsigned*)((const char*)(gbase) + (voff)[_i]), (LAS unsigned*)(lds + (bufoff) + ldsw + _i * 8192), 16, 0, 0); } while (0)
#define PG8_LDA(dst, b, h) do { _Pragma("unroll") for (int m = 0; m < 4; ++m) _Pragma("unroll") for (int k = 0; k < 2; ++k) dst[m][k] = *(const LAS bf16x8*)(lds + PG8_SA(b, h) + aoff + m * 2048 + k * 1024); } while (0)
#define PG8_LDB(dst, b, h) do { _Pragma("unroll") for (int n = 0; n < 2; ++n) _Pragma("unroll") for (int k = 0; k < 2; ++k) dst[n][k] = *(const LAS bf16x8*)(lds + PG8_SB(b, h) + boff + n * 2048 + k * 1024); } while (0)
#define PG8_MMA(ai, bj, At, Bt) do { __builtin_amdgcn_s_setprio(1); _Pragma("unroll") for (int m = 0; m < 4; ++m) _Pragma("unroll") for (int n = 0; n < 2; ++n) _Pragma("unroll") for (int k = 0; k < 2; ++k) \
        acc[ai][bj][m][n] = __builtin_amdgcn_mfma_f32_16x16x32_bf16(Bt[n][k], At[m][k], acc[ai][bj][m][n], 0, 0, 0); __builtin_amdgcn_s_setprio(0); } while (0)
#define PG8_WAIT_V(n) asm volatile("s_waitcnt vmcnt(" #n ")" ::: "memory")
#define PG8_WAIT_L(n) asm volatile("s_waitcnt lgkmcnt(" #n ")" ::: "memory")
#define PG8_BAR __builtin_amdgcn_s_barrier()
#define PG8_SCHED __builtin_amdgcn_sched_barrier(0)
    Unit cur, nxt; int ui = 0;
    if (!S.next(0, cur)) return;
    f32x4 acc[2][2][4][2];
#pragma unroll
    for (int a = 0; a < 2; ++a)
#pragma unroll
        for (int b = 0; b < 2; ++b)
#pragma unroll
            for (int m = 0; m < 4; ++m)
#pragma unroll
                for (int n = 0; n < 2; ++n) acc[a][b][m][n] = (f32x4){0.f, 0.f, 0.f, 0.f};
    bf16x8 At[4][2], B0[2][2], B1[2][2];
    const char* cA = (const char*)g.A + (size_t)cur.pm * tstep; const char* cB = (const char*)g.Bt + (size_t)cur.pn * tstep;
    S.a_ready(cur);
    if constexpr (SP2) {
        PG8_STAGE(PG8_SB(0, 0), cB, voffB); PG8_STAGE(PG8_SB(0, 1), cB + hstep, voffB); PG8_STAGE(PG8_SA(0, 0), cA, voffA); PG8_STAGE(PG8_SA(0, 1), cA + hstep, voffA);
        if (wr == 1) PG8_BAR;
        PG8_WAIT_V(2); PG8_BAR;
        PG8_STAGE(PG8_SB(1, 0), cB + kstep, voffB); PG8_STAGE(PG8_SA(1, 0), cA + kstep, voffA); PG8_STAGE(PG8_SB(1, 1), cB + hstep + kstep, voffB);
        PG8_WAIT_V(6); PG8_BAR;
    } else {
        PG8_STAGE(PG8_SB(0, 0), cB, voffB); PG8_STAGE(PG8_SA(0, 0), cA, voffA); PG8_STAGE(PG8_SB(0, 1), cB + hstep, voffB); PG8_STAGE(PG8_SA(0, 1), cA + hstep, voffA);
        if (wr == 1) PG8_BAR;
        PG8_WAIT_V(4); PG8_BAR;
        PG8_STAGE(PG8_SB(1, 0), cB + kstep, voffB); PG8_STAGE(PG8_SA(1, 0), cA + kstep, voffA); PG8_STAGE(PG8_SB(1, 1), cB + hstep + kstep, voffB);
        PG8_WAIT_V(6); PG8_BAR;
    }
    for (;;) {
        const bool has_next = S.next(ui + 1, nxt);
        const char* nA = has_next ? (const char*)g.A + (size_t)nxt.pm * tstep : cA; const char* nB = has_next ? (const char*)g.Bt + (size_t)nxt.pn * tstep : cB;
        for (int t = 0; t < nt; t += 2) {
            const bool last = (t == nt - 2);
            const char* a1 = cA + (size_t)(t + 1) * kstep;
            const char* a2 = last ? nA : cA + (size_t)(t + 2) * kstep; const char* b2 = last ? nB : cB + (size_t)(t + 2) * kstep;
            const char* a3 = a2 + kstep; const char* b3 = b2 + kstep;
            if (last && has_next) S.a_ready(nxt);
            if constexpr (SP2) {
            PG8_LDB(B0, 0, 0); PG8_LDB(B1, 0, 1); PG8_SCHED; PG8_LDA(At, 0, 0); PG8_STAGE(PG8_SA(1, 1), a1 + hstep, voffA);
            PG8_WAIT_V(8); PG8_WAIT_L(0); PG8_BAR; PG8_MMA(0, 0, At, B0); PG8_MMA(0, 1, At, B1); PG8_BAR; PG8_SCHED;
            PG8_LDA(At, 0, 1); PG8_STAGE(PG8_SB(0, 0), b2, voffB); PG8_STAGE(PG8_SB(0, 1), b2 + hstep, voffB); PG8_STAGE(PG8_SA(0, 0), a2, voffA);
            PG8_WAIT_V(8); PG8_WAIT_L(0); PG8_BAR; PG8_MMA(1, 0, At, B0); PG8_MMA(1, 1, At, B1); PG8_BAR; PG8_SCHED;
            PG8_LDB(B0, 1, 0); PG8_LDB(B1, 1, 1); PG8_SCHED; PG8_LDA(At, 1, 0); PG8_STAGE(PG8_SA(0, 1), a2 + hstep, voffA);
            PG8_WAIT_V(8); PG8_WAIT_L(0); PG8_BAR; PG8_MMA(0, 0, At, B0); PG8_MMA(0, 1, At, B1); PG8_BAR; PG8_SCHED;
            PG8_LDA(At, 1, 1); PG8_STAGE(PG8_SB(1, 0), b3, voffB); PG8_STAGE(PG8_SB(1, 1), b3 + hstep, voffB); PG8_STAGE(PG8_SA(1, 0), a3, voffA);
            PG8_WAIT_V(8); PG8_WAIT_L(0); PG8_BAR; PG8_MMA(1, 0, At, B0); PG8_MMA(1, 1, At, B1); PG8_BAR; PG8_SCHED;
            } else {
            PG8_LDB(B0, 0, 0); PG8_SCHED; PG8_LDA(At, 0, 0); PG8_STAGE(PG8_SA(1, 1), a1 + hstep, voffA);
            PG8_WAIT_L(8); PG8_BAR; PG8_WAIT_L(0); PG8_MMA(0, 0, At, B0); PG8_BAR; PG8_SCHED;
            PG8_LDB(B1, 0, 1); PG8_STAGE(PG8_SB(0, 0), b2, voffB);
            PG8_BAR; PG8_WAIT_L(0); PG8_MMA(0, 1, At, B1); PG8_BAR;
            PG8_LDA(At, 0, 1); PG8_STAGE(PG8_SA(0, 0), a2, voffA);
            PG8_BAR; PG8_WAIT_L(0); PG8_MMA(1, 0, At, B0); PG8_BAR; PG8_SCHED;
            PG8_STAGE(PG8_SB(0, 1), b2 + hstep, voffB);
            PG8_WAIT_V(6); PG8_BAR; PG8_MMA(1, 1, At, B1); PG8_BAR;
            PG8_LDB(B0, 1, 0); PG8_SCHED; PG8_LDA(At, 1, 0); PG8_STAGE(PG8_SA(0, 1), a2 + hstep, voffA);
            PG8_WAIT_L(8); PG8_BAR; PG8_WAIT_L(0); PG8_MMA(0, 0, At, B0); PG8_BAR; PG8_SCHED;
            PG8_LDB(B1, 1, 1); PG8_STAGE(PG8_SB(1, 0), b3, voffB);
            PG8_BAR; PG8_WAIT_L(0); PG8_MMA(0, 1, At, B1); PG8_BAR;
            PG8_LDA(At, 1, 1); PG8_STAGE(PG8_SA(1, 0), a3, voffA);
            PG8_BAR; PG8_WAIT_L(0); PG8_MMA(1, 0, At, B0); PG8_BAR; PG8_SCHED;
            PG8_STAGE(PG8_SB(1, 1), b3 + hstep, voffB);
            PG8_WAIT_V(6); PG8_BAR; PG8_MMA(1, 1, At, B1); PG8_BAR;
            }
        }
        if constexpr (ALIGN_EPI) { if (wr == 0) PG8_BAR; }
        if constexpr (!Epi::AFTER_DRAIN) { E(acc, cur, wr, wc, fr, fq); S.done(cur); }
        if (!has_next) break;
#pragma unroll
        for (int a = 0; a < 2; ++a)
#pragma unroll
            for (int b = 0; b < 2; ++b)
#pragma unroll
                for (int m = 0; m < 4; ++m)
#pragma unroll
                    for (int n = 0; n < 2; ++n) acc[a][b][m][n] = (f32x4){0.f, 0.f, 0.f, 0.f};
        cur = nxt; cA = nA; cB = nB; ++ui;
        if constexpr (ALIGN_EPI) { if (wr == 1) PG8_BAR; }
    }
    PG8_WAIT_V(0);
    if constexpr (!ALIGN_EPI) { if (wr == 0) PG8_BAR; }
    PG8_BAR;
#undef PG8_SA
#undef PG8_SB
#undef PG8_STAGE
#undef PG8_LDA
#undef PG8_LDB
#undef PG8_MMA
#undef PG8_WAIT_V
#undef PG8_WAIT_L
#undef PG8_BAR
#undef PG8_SCHED
}
}

struct Args {
    const float* x; const float* ln1_g; const float* w_in; const float* diff_lambda; const float* rel_bias; const float* gate_w; const float* gate_b;
    const float* decay_logit; const float* head_gain; const float* w_o; const float* ln2_g; const float* w_up; const float* conv_w; const float* conv_b;
    const float* w_down; const float* final_g;
    float* out; unsigned char* ws; int ph_lo, ph_hi;
};

struct TItem { const float* src; const float* gk; bf16_t* dst; int N, K; float cs; };
__device__ __forceinline__ TItem titem_decode(const Args& a, int it) {
    constexpr int I_IN = (D / 64) * (INW / 32), I_O = (D / 64) * (D / 32), I_UP = (D / 64) * (UPW / 32), I_DN = (DFF / 64) * (D / 32), I_L = I_IN + I_O + I_UP + I_DN;
    const int L = it / I_L; int r = it % I_L; unsigned char* wl = a.ws + WS_W + (size_t)L * W_LAYER; TItem t;
    if (r < I_IN) { const int nblk = INW / 32, kb = r / nblk, n0 = (r % nblk) * 32, k0 = kb * 64;
        t.cs = ((n0 >= GQ && n0 < GK) || (n0 >= SRC_RK && n0 < SRC_RV)) ? 0.125f : 1.f; t.N = INW; t.K = D; t.src = a.w_in + (size_t)L * D * INW + (size_t)k0 * INW + n0; t.gk = a.ln1_g + L * D + k0;
        const int dn = n0 < SRC_GA ? n0 : (n0 < SRC_GA + 32 ? GAF + (n0 - SRC_GA) : n0 - 32);
        t.dst = (bf16_t*)(wl + W_IN) + (size_t)dn * D + k0; return t; }
    r -= I_IN;
    if (r < I_O) { const int nblk = D / 32, kb = r / nblk, n0 = (r % nblk) * 32, k0 = kb * 64;
        t.cs = 1.f; t.N = D; t.K = D; t.src = a.w_o + (size_t)L * D * D + (size_t)k0 * D + n0; t.gk = nullptr; t.dst = (bf16_t*)(wl + W_O) + (size_t)n0 * D + k0; return t; }
    r -= I_O;
    if (r < I_UP) { const int nblk = UPW / 32, kb = r / nblk, n0 = (r % nblk) * 32, k0 = kb * 64;
        const int c = n0 < DFF ? n0 : n0 - DFF; const int dst = (c >> 7) * 256 + (c & 127) + (n0 < DFF ? 0 : 128);
        t.cs = 1.f; t.N = UPW; t.K = D; t.src = a.w_up + (size_t)L * D * UPW + (size_t)k0 * UPW + n0; t.gk = a.ln2_g + L * D + k0; t.dst = (bf16_t*)(wl + W_UP) + (size_t)dst * D + k0; return t; }
    r -= I_UP;
    { const int nblk = D / 32, kb = r / nblk, n0 = (r % nblk) * 32, k0 = kb * 64;
        t.cs = 1.f; t.N = D; t.K = DFF; t.src = a.w_down + (size_t)L * DFF * D + (size_t)k0 * D + n0; t.gk = nullptr; t.dst = (bf16_t*)(wl + W_DN) + (size_t)n0 * DFF + k0; return t; }
}
#define TI_LOAD(R, GV, t) do { const float* sp_ = (t).src + (size_t)(lane >> 5) * (t).N + (lane & 31); \
    _Pragma("unroll") for (int i = 0; i < 32; ++i) R[i] = sp_[(size_t)(2 * i) * (t).N]; \
    if ((t).gk) { const f32x4 g0_ = *(const f32x4*)((t).gk + 8 * (lane & 7)), g1_ = *(const f32x4*)((t).gk + 8 * (lane & 7) + 4); \
        GV[0] = g0_[0] * (t).cs; GV[1] = g0_[1] * (t).cs; GV[2] = g0_[2] * (t).cs; GV[3] = g0_[3] * (t).cs; GV[4] = g1_[0] * (t).cs; GV[5] = g1_[1] * (t).cs; GV[6] = g1_[2] * (t).cs; GV[7] = g1_[3] * (t).cs; } \
    else { _Pragma("unroll") for (int e = 0; e < 8; ++e) GV[e] = (t).cs; } } while (0)
#define TI_PROC(R, GV, t) do { \
    _Pragma("unroll") for (int i = 0; i < 32; ++i) scr[(2 * i + (lane >> 5)) * 33 + (lane & 31)] = R[i]; \
    LDS_WAIT(); asm volatile("" ::: "memory"); \
    const int c_ = lane & 7; \
    _Pragma("unroll") for (int j = 0; j < 4; ++j) { const int n_ = (lane >> 3) + 8 * j; const LAS float* s_ = scr + (8 * c_) * 33 + n_; \
        u32x4 o_; o_.x = cvt_pk_bf16(s_[0 * 33] * GV[0], s_[1 * 33] * GV[1]); o_.y = cvt_pk_bf16(s_[2 * 33] * GV[2], s_[3 * 33] * GV[3]); \
        o_.z = cvt_pk_bf16(s_[4 * 33] * GV[4], s_[5 * 33] * GV[5]); o_.w = cvt_pk_bf16(s_[6 * 33] * GV[6], s_[7 * 33] * GV[7]); \
        *(u32x4*)((t).dst + (size_t)n_ * (t).K + 8 * c_) = o_; } \
    LDS_WAIT(); asm volatile("" ::: "memory"); } while (0)

__device__ __forceinline__ void phase_prologue(const Args& a, LAS unsigned char* lds) {
    const int tid = otid(), lane = tid & 63, wave = tid >> 6, G = gridDim.x;
    LAS float* scr = (LAS float*)(lds + wave * 16384);
    const int gw = blockIdx.x * NWAVE + wave, NGW = G * NWAVE;
    constexpr int I_IN = (D / 64) * (INW / 32), I_O = (D / 64) * (D / 32), I_UP = (D / 64) * (UPW / 32), I_DN = (DFF / 64) * (D / 32), I_L = I_IN + I_O + I_UP + I_DN, I_ALL = DEPTH * I_L;
    { float ra[32], rb[32], ga[8], gb[8]; TItem ta, tb;
        if (gw < I_ALL) { ta = titem_decode(a, gw); TI_LOAD(ra, ga, ta); }
        for (int it = gw; it < I_ALL; it += 2 * NGW) {
            const bool hasB = it + NGW < I_ALL;
            if (hasB) { tb = titem_decode(a, it + NGW); TI_LOAD(rb, gb, tb); }
            TI_PROC(ra, ga, ta);
            if (it + 2 * NGW < I_ALL) { ta = titem_decode(a, it + 2 * NGW); TI_LOAD(ra, ga, ta); }
            if (hasB) TI_PROC(rb, gb, tb);
        } }
    { const int gt = blockIdx.x * NTHR + tid, NT_ = G * NTHR; constexpr int PER = (INP - INW) * D * 2 / 16;
        for (int i = gt; i < DEPTH * PER; i += NT_) { const int L = i / PER, j = i % PER;
            *(u32x4*)(a.ws + WS_W + (size_t)L * W_LAYER + W_IN + (size_t)INW * D * 2 + (size_t)j * 16) = (u32x4){0u, 0u, 0u, 0u}; } }
    { u64_t* ss0 = (u64_t*)(a.ws + WS_SS); bf16_t* xb = (bf16_t*)(a.ws + WS_XB);
        for (int m = gw; m < M; m += NGW) { const f32x4* xr = (const f32x4*)(a.x + (size_t)m * D) + lane; f32x4* orow = (f32x4*)(a.out + (size_t)m * D) + lane; u32x2* brow = (u32x2*)(xb + (size_t)m * D) + lane; float s = 0.f;
#pragma unroll
            for (int j = 0; j < 8; ++j) { const f32x4 v = xr[64 * j]; orow[64 * j] = v; s += (v[0] * v[0] + v[1] * v[1]) + (v[2] * v[2] + v[3] * v[3]);
                u32x2 w; w.x = cvt_pk_bf16(v[0], v[1]); w.y = cvt_pk_bf16(v[2], v[3]); brow[64 * j] = w; }
            s = wave_sum(s); if (lane == 0) ss0[m] = (u64_t)(s * SS_FX + 0.5f); } }
    { const int gt = blockIdx.x * NTHR + tid, NT_ = G * NTHR;
        f32x2* rope = (f32x2*)(a.ws + WS_ROPE);
        for (int i = gt; i < T * 32; i += NT_) { const int pos = i >> 5, f = i & 31;
            const float ex = (float)f * (1.0f / 31.0f); const float inv = 1.0f / __builtin_amdgcn_exp2f(ex * 13.287712379549449f);
            const float ang = (float)pos * inv; const double rev = (double)ang * 0.15915494309189535; const float fr = (float)(rev - __builtin_rint(rev));
            rope[i] = (f32x2){__builtin_amdgcn_cosf(fr), __builtin_amdgcn_sinf(fr)}; }
        float* btab = (float*)(a.ws + WS_BTAB);
        for (int i = gt; i < 8 * BTAB_N; i += NT_) { const int h = i / BTAB_N, rel = i % BTAB_N - BTAB_OFF; const int n = rel < 0 ? -rel : rel;
            int bk = n; if (n >= 8) { bk = 8 + (n >= 12) + (n >= 16) + (n >= 23) + (n >= 32) + (n >= 46) + (n >= 64) + (n >= 91); }
            if (rel > 0) bk += 16; btab[i] = a.rel_bias[bk * 8 + h] * 8.0f; }
        if (gt < DEPTH) { const float* lp = a.diff_lambda + gt * 256; float s1 = 0.f, s2 = 0.f; for (int j = 0; j < 64; ++j) { s1 += lp[j] * lp[64 + j]; s2 += lp[128 + j] * lp[192 + j]; }
            float e1 = __expf(s1), e2 = __expf(s2); asm volatile("" : "+v"(e1), "+v"(e2));
            const float li = 0.8f - 0.6f * __expf(-0.3f * (float)gt); ((float*)(a.ws + WS_LAM))[gt] = (e1 - e2) + li; } }
}

namespace att {
constexpr int LD = INP;
constexpr float SCALE = 0.125f, THR = 8.f;
constexpr int SHM_V = 64 * 128 * 2, SHM_K = 64 * 64 * 2;
constexpr int NBUF = 3;
constexpr int L_V = 0, L_K = NBUF * SHM_V, L_WS = L_K + NBUF * SHM_K, L_TAB = L_WS + NWAVE * 64 * 4;
#define KSWZ64(row, colB) ((row) * 128 + ((colB) ^ ((((row) >> 1) & 7) << 4)))
#define SBAR() __builtin_amdgcn_sched_barrier(0)
__device__ __forceinline__ int crow(int r, int hi) { return (r & 3) + 8 * (r >> 2) + 4 * hi; }
#define MX3(a, b, c) __builtin_fmaxf(__builtin_fmaxf((a), (b)), (c))
__device__ __forceinline__ void partialSM(f32x16& p0, f32x16& p1, float& m_reg, float& mn, float& alpha, float boff) {
    constexpr float C = SCALE * 1.4426950408889634f;
    float a = MX3(p0[0], p0[1], p1[0]), b = MX3(p0[2], p0[3], p1[1]); a = MX3(a, p1[2], p1[3]);
#pragma unroll
    for (int r = 4; r < 16; r += 4) { a = MX3(a, p0[r], p0[r + 1]); b = MX3(b, p0[r + 2], p0[r + 3]); a = MX3(a, p1[r], p1[r + 1]); b = MX3(b, p1[r + 2], p1[r + 3]); }
    float pmax = __builtin_fmaxf(a, b);
    { auto rr = __builtin_amdgcn_permlane32_swap(__float_as_uint(pmax), __float_as_uint(pmax), false, false);
      pmax = fmaxf(__uint_as_float(rr[0]), __uint_as_float(rr[1])) + boff; }
    if (__builtin_expect(__all(pmax - m_reg <= THR / SCALE), 1)) { mn = m_reg; alpha = 1.f; }
    else { mn = fmaxf(m_reg, pmax); alpha = __builtin_amdgcn_exp2f((m_reg - mn) * C); m_reg = mn; }
    const float mnC = (boff - mn) * C;
#pragma unroll
    for (int r = 0; r < 16; ++r) p0[r] = fmaf(p0[r], C, mnC);
#pragma unroll
    for (int r = 0; r < 16; ++r) p1[r] = fmaf(p1[r], C, mnC);
#pragma unroll
    for (int r = 0; r < 16; ++r) p0[r] = __builtin_amdgcn_exp2f(p0[r]);
}
__device__ __forceinline__ void finishSM(f32x16& p0, f32x16& p1, float alpha, float& l_reg, bf16x8& pa0, bf16x8& pa1, bf16x8& pa2, bf16x8& pa3) {
#pragma unroll
    for (int r = 0; r < 16; ++r) p1[r] = __builtin_amdgcn_exp2f(p1[r]);
    float ps = 0;
#pragma unroll
    for (int r = 0; r < 16; ++r) ps += p0[r];
#pragma unroll
    for (int r = 0; r < 16; ++r) ps += p1[r];
    { auto rr = __builtin_amdgcn_permlane32_swap(__float_as_uint(ps), __float_as_uint(ps), false, false);
      ps = __uint_as_float(rr[0]) + __uint_as_float(rr[1]); }
    l_reg = l_reg * alpha + ps;
#define PK4(P, BASE, OUT) do { unsigned a0 = cvt_pk_bf16(P[BASE + 0], P[BASE + 1]), a1 = cvt_pk_bf16(P[BASE + 2], P[BASE + 3]);   \
    unsigned b0 = cvt_pk_bf16(P[BASE + 4], P[BASE + 5]), b1 = cvt_pk_bf16(P[BASE + 6], P[BASE + 7]);                              \
    auto r0 = __builtin_amdgcn_permlane32_swap(a0, b0, false, false); auto r1 = __builtin_amdgcn_permlane32_swap(a1, b1, false, false); \
    u32x4 w = {r0[0], r1[0], r0[1], r1[1]}; OUT = __builtin_bit_cast(bf16x8, w); } while (0)
    PK4(p0, 0, pa0); PK4(p0, 8, pa1); PK4(p1, 0, pa2); PK4(p1, 8, pa3);
#undef PK4
}
__device__ __forceinline__ float qkt(f32x16& p0, f32x16& p1, const LAS char* Ks, const bf16x8* qr, int r32, int hi, int dlt, float cL, float cR, const LAS float* tabL) {
    bf16x8 b0[4], b1[4];
#pragma unroll
    for (int d0 = 0; d0 < 4; ++d0) { const int cb = d0 * 32 + hi * 16;
        b0[d0] = *(const LAS bf16x8*)(Ks + KSWZ64(r32, cb)); b1[d0] = *(const LAS bf16x8*)(Ks + KSWZ64(32 + r32, cb)); }
    if (dlt <= -191 || dlt >= 159) {
        const f32x16 z = f32x16{};
        p0 = __builtin_amdgcn_mfma_f32_32x32x16_bf16(b0[0], qr[0], z, 0, 0, 0); p1 = __builtin_amdgcn_mfma_f32_32x32x16_bf16(b1[0], qr[0], z, 0, 0, 0);
#pragma unroll
        for (int d0 = 1; d0 < 4; ++d0) { p0 = __builtin_amdgcn_mfma_f32_32x32x16_bf16(b0[d0], qr[d0], p0, 0, 0, 0); p1 = __builtin_amdgcn_mfma_f32_32x32x16_bf16(b1[d0], qr[d0], p1, 0, 0, 0); }
        return dlt < 0 ? cL : cR;
    }
    const LAS float* tp = tabL + (dlt + BTAB_OFF + 4 * hi - r32);
#pragma unroll
    for (int r = 0; r < 16; ++r) { p0[r] = tp[(r & 3) + 8 * (r >> 2)]; p1[r] = tp[32 + (r & 3) + 8 * (r >> 2)]; }
    asm volatile("s_waitcnt lgkmcnt(0)" ::: "memory");
#pragma unroll
    for (int d0 = 0; d0 < 4; ++d0) { p0 = __builtin_amdgcn_mfma_f32_32x32x16_bf16(b0[d0], qr[d0], p0, 0, 0, 0); p1 = __builtin_amdgcn_mfma_f32_32x32x16_bf16(b1[d0], qr[d0], p1, 0, 0, 0); }
    return 0.f;
}
__device__ __forceinline__ int v_st(int k, int c) { const int kk = (k & ~0xC) | ((k & 4) << 1) | ((k & 8) >> 1); return ((kk >> 3) * 4 + (c >> 5)) * 512 + ((kk & 7) * 32 + (c & 31)) * 2; }
__device__ __forceinline__ int v_rd_base(int lane) { return ((lane & 3) << 3) | (((lane >> 2) & 3) << 6) | (((lane >> 4) & 1) << 5) | (((lane >> 5) & 1) << 8); }
constexpr int v_rd_off(int d0, int ks, int half) { return d0 * 512 + ks * 4096 + half * 2048; }
template <int OFF> __device__ __forceinline__ s16x4 tr_read(int vb) {
    s16x4 r; asm volatile("ds_read_b64_tr_b16 %0, %1 offset:%2" : "=&v"(r) : "v"(vb), "i"(OFF) : "memory"); return r;
}
template <int D0> __device__ __forceinline__ void pv_one(f32x16& od, int vb, bf16x8 pa0, bf16x8 pa1, bf16x8 pa2, bf16x8 pa3) {
    const s16x4 l0 = tr_read<v_rd_off(D0, 0, 0)>(vb), h0 = tr_read<v_rd_off(D0, 0, 1)>(vb), l1 = tr_read<v_rd_off(D0, 1, 0)>(vb), h1 = tr_read<v_rd_off(D0, 1, 1)>(vb);
    const s16x4 l2 = tr_read<v_rd_off(D0, 2, 0)>(vb), h2 = tr_read<v_rd_off(D0, 2, 1)>(vb), l3 = tr_read<v_rd_off(D0, 3, 0)>(vb), h3 = tr_read<v_rd_off(D0, 3, 1)>(vb);
    asm volatile("s_waitcnt lgkmcnt(0)" ::: "memory"); SBAR();
#define PK(L, H) (bf16x8){L[0], L[1], L[2], L[3], H[0], H[1], H[2], H[3]}
    od = __builtin_amdgcn_mfma_f32_32x32x16_bf16(pa0, PK(l0, h0), od, 0, 0, 0);
    od = __builtin_amdgcn_mfma_f32_32x32x16_bf16(pa1, PK(l1, h1), od, 0, 0, 0);
    od = __builtin_amdgcn_mfma_f32_32x32x16_bf16(pa2, PK(l2, h2), od, 0, 0, 0);
    od = __builtin_amdgcn_mfma_f32_32x32x16_bf16(pa3, PK(l3, h3), od, 0, 0, 0);
#undef PK
}
__device__ __forceinline__ void pv_d0(f32x16* o, int vb, bf16x8 pa0, bf16x8 pa1, bf16x8 pa2, bf16x8 pa3) {
    pv_one<0>(o[0], vb, pa0, pa1, pa2, pa3); pv_one<1>(o[1], vb, pa0, pa1, pa2, pa3); pv_one<2>(o[2], vb, pa0, pa1, pa2, pa3); pv_one<3>(o[3], vb, pa0, pa1, pa2, pa3);
}

__device__ __forceinline__ void attn_unit(int b, int h, int qb, const bf16_t* __restrict__ proj, const float* __restrict__ btab, float lam, float outscale,
                                          const float* __restrict__ gain, float* o1scr, bf16_t* merged, LAS char* lds) {
    const int tid = otid(), wid = __builtin_amdgcn_readfirstlane(tid >> 6), lane = tid & 63, r32 = lane & 31, hi = lane >> 5;
    const long rowbase = (long)b * T; const int qw = qb * 256 + wid * 32;
    LAS char* V_lds = lds + L_V; LAS char* K_lds = lds + L_K;
    LAS float* wsl = (LAS float*)(lds + L_WS) + wid * 64; LAS float* li_l = wsl; LAS float* al_l = wsl + 32;
    LAS float* tabL = (LAS float*)(lds + L_TAB);
    __syncthreads();
    if (tid < BTAB_N) tabL[tid] = btab[h * BTAB_N + tid];
    __syncthreads();
    const float cL = tabL[0], cR = tabL[BTAB_N - 1];
    unsigned koff, voffA, voffB;
    { const int row = wid * 8 + (lane >> 3), c16 = (lane & 7) ^ ((row >> 1) & 7); koff = (unsigned)((row * LD + c16 * 8) * 2);
      const int within = lane & 31;
#pragma unroll
      for (int i = 0; i < 2; ++i) { const int sub = (2 * wid + i) * 2 + (lane >> 5); const int kk = (sub >> 2) * 8 + (within >> 2);
          const int k = (kk & ~0xC) | ((kk & 4) << 1) | ((kk & 8) >> 1), c = (sub & 3) * 32 + (within & 3) * 8;
          const unsigned o = (unsigned)((k * LD + c) * 2); if (i == 0) voffA = o; else voffB = o; } }
    const int vb0 = (int)(unsigned)(uintptr_t)V_lds + v_rd_base(lane);
    const bf16_t* Vh = proj + rowbase * LD + OV + h * 128;
#pragma unroll 1
    for (int s = 0; s < 2; ++s) {
        const int hq = 2 * h + s;
        const bf16_t* Kh = proj + rowbase * LD + OKK + hq * 64;
        const bf16_t* Qw = proj + (rowbase + qw + r32) * LD + OQ + hq * 64 + hi * 8;
        float m_reg = -1e30f, l_reg = 0; f32x16 o[4]; bf16x8 qr[4];
#pragma unroll
        for (int d0 = 0; d0 < 4; ++d0) { o[d0] = f32x16{}; qr[d0] = *(const bf16x8*)(Qw + d0 * 16); }
#define DMA_TILE(t, buf) do { const char* vt_ = (const char*)Vh + (size_t)(t) * (64 * LD * 2); const char* kt_ = (const char*)Kh + (size_t)(t) * (64 * LD * 2); \
        __builtin_amdgcn_global_load_lds((const unsigned*)(kt_ + koff), (LAS unsigned*)(K_lds + (buf) * SHM_K + wid * 1024), 16, 0, 0); \
        __builtin_amdgcn_global_load_lds((const unsigned*)(vt_ + voffA), (LAS unsigned*)(V_lds + (buf) * SHM_V + (2 * wid) * 1024), 16, 0, 0); \
        __builtin_amdgcn_global_load_lds((const unsigned*)(vt_ + voffB), (LAS unsigned*)(V_lds + (buf) * SHM_V + (2 * wid + 1) * 1024), 16, 0, 0); } while (0)
#define WAITBAR(N) asm volatile("s_waitcnt vmcnt(" #N ") lgkmcnt(0)\n\ts_barrier" ::: "memory")
#define RESC(a) do { if (__any((a) < 1.f)) { if (hi == 0) al_l[r32] = (a); asm volatile("s_waitcnt lgkmcnt(0)" ::: "memory"); \
        _Pragma("unroll") for (int d = 0; d < 4; ++d) _Pragma("unroll") for (int r = 0; r < 16; ++r) o[d][r] *= al_l[crow(r, hi)]; } } while (0)
        f32x16 pA0, pA1, pB0, pB1; float mnA, mnB, alA, alB, bo; bf16x8 pa0, pa1, pa2, pa3; constexpr int NT = T / 64;
        asm volatile("s_waitcnt vmcnt(0) lgkmcnt(0)" ::: "memory"); __syncthreads();
        DMA_TILE(0, 0); DMA_TILE(1, 1);
        WAITBAR(3);
        bo = qkt(pA0, pA1, K_lds, qr, r32, hi, 0 - qw, cL, cR, tabL); partialSM(pA0, pA1, m_reg, mnA, alA, bo);
        int bc = 1, bp = 0, bn = 2;
#define ROT() do { const int t_ = bp; bp = bc; bc = bn; bn = t_; } while (0)
#pragma unroll 1
        for (int j = 1; j + 1 < NT; j += 2) {
            WAITBAR(0);
            DMA_TILE(j + 1, bn);
            SBAR(); bo = qkt(pB0, pB1, K_lds + bc * SHM_K, qr, r32, hi, j * 64 - qw, cL, cR, tabL);
            finishSM(pA0, pA1, alA, l_reg, pa0, pa1, pa2, pa3); SBAR();
            pv_d0(o, vb0 + bp * SHM_V, pa0, pa1, pa2, pa3); partialSM(pB0, pB1, m_reg, mnB, alB, bo);
            RESC(alB); ROT();
            WAITBAR(0);
            if (j + 2 < NT) DMA_TILE(j + 2, bn);
            SBAR(); bo = qkt(pA0, pA1, K_lds + bc * SHM_K, qr, r32, hi, (j + 1) * 64 - qw, cL, cR, tabL);
            finishSM(pB0, pB1, alB, l_reg, pa0, pa1, pa2, pa3); SBAR();
            pv_d0(o, vb0 + bp * SHM_V, pa0, pa1, pa2, pa3); partialSM(pA0, pA1, m_reg, mnA, alA, bo);
            RESC(alA); ROT();
        }
        WAITBAR(0);
        SBAR(); bo = qkt(pB0, pB1, K_lds + bc * SHM_K, qr, r32, hi, (NT - 1) * 64 - qw, cL, cR, tabL);
        finishSM(pA0, pA1, alA, l_reg, pa0, pa1, pa2, pa3); SBAR();
        pv_d0(o, vb0 + bp * SHM_V, pa0, pa1, pa2, pa3); partialSM(pB0, pB1, m_reg, mnB, alB, bo);
        RESC(alB);
        finishSM(pB0, pB1, alB, l_reg, pa0, pa1, pa2, pa3); SBAR();
        pv_d0(o, vb0 + bc * SHM_V, pa0, pa1, pa2, pa3);
#undef ROT
#undef DMA_TILE
#undef WAITBAR
#undef RESC
        if (hi == 0) li_l[r32] = l_reg; asm volatile("s_waitcnt lgkmcnt(0)" ::: "memory");
        float rli[16];
#pragma unroll
        for (int r = 0; r < 16; ++r) rli[r] = __builtin_amdgcn_rcpf(li_l[crow(r, hi)]);
        int tl = tid; asm volatile("" : "+v"(tl));
        f32x4* o1p = (f32x4*)(o1scr + (size_t)tl * 64);
        if (s == 0) {
#pragma unroll
            for (int d0 = 0; d0 < 4; ++d0)
#pragma unroll
                for (int r4 = 0; r4 < 4; ++r4)
                    o1p[d0 * 4 + r4] = (f32x4){o[d0][4 * r4] * rli[4 * r4], o[d0][4 * r4 + 1] * rli[4 * r4 + 1], o[d0][4 * r4 + 2] * rli[4 * r4 + 2], o[d0][4 * r4 + 3] * rli[4 * r4 + 3]};
        } else {
#pragma unroll
            for (int d0 = 0; d0 < 4; ++d0)
#pragma unroll
                for (int r4 = 0; r4 < 4; ++r4) { const f32x4 p = o1p[d0 * 4 + r4];
#pragma unroll
                    for (int e = 0; e < 4; ++e) o[d0][4 * r4 + e] = p[e] - lam * (o[d0][4 * r4 + e] * rli[4 * r4 + e]); }
            float ssq[16];
#pragma unroll
            for (int r = 0; r < 16; ++r) { float a2 = 0.f;
#pragma unroll
                for (int d0 = 0; d0 < 4; ++d0) a2 += o[d0][r] * o[d0][r];
                a2 += __shfl_xor(a2, 1); a2 += __shfl_xor(a2, 2); a2 += __shfl_xor(a2, 4); a2 += __shfl_xor(a2, 8); a2 += __shfl_xor(a2, 16);
                ssq[r] = __builtin_amdgcn_rsqf(a2 * (1.0f / 128.0f) + EPS) * outscale; }
            const int r32l = tl & 31, hil = (tl >> 5) & 1;
            float gn[4];
#pragma unroll
            for (int d0 = 0; d0 < 4; ++d0) gn[d0] = gain[h * 128 + d0 * 32 + r32l];
            bf16_t* Ow = merged + (rowbase + qw + 4 * hil) * D + h * 128 + r32l;
#pragma unroll
            for (int r = 0; r < 16; ++r) { bf16_t* orp = Ow + (long)((r & 3) + 8 * (r >> 2)) * D;
#pragma unroll
                for (int d0 = 0; d0 < 4; ++d0) orp[d0 * 32] = (bf16_t)f2bf(o[d0][r] * ssq[r] * gn[d0]); }
        }
    }
}
#undef SBAR
}

namespace lin {
constexpr int LD = INP, PT = 72;
constexpr int L_CUM = 0, L_VT = 32768, L_QK = L_VT + 128 * PT * 2, L_P = L_QK + 4 * 64 * PT * 2, L_OL = L_QK, OLP = 132;
__device__ __forceinline__ int crow(int r, int hi) { return (r & 3) + 8 * (r >> 2) + 4 * hi; }
__device__ __forceinline__ int seqidx(int b, int hl, int dir, int c) { return ((b * 8 + hl) * 2 + dir) * 64 + c; }

__device__ __forceinline__ void build_cum(const Args& a, int L, int hl, long R0, const bf16_t* __restrict__ proj, LAS unsigned char* lds) {
    const int tid = otid(); LAS float* cum = (LAS float*)(lds + L_CUM);
    const int k = tid & 63, dir = (tid >> 6) & 1, isub = tid >> 7;
    if (hl < 4) {
        float gw[16];
#pragma unroll
        for (int r = 0; r < 16; ++r) gw[r] = a.gate_w[((size_t)(L * 2 + dir) * 16 + r) * 256 + hl * 64 + k];
        const float gb = a.gate_b[(L * 2 + dir) * 256 + hl * 64 + k];
#pragma unroll 4
        for (int it = 0; it < 16; ++it) { const int i = isub + 4 * it; const bf16_t* ga = proj + (R0 + i) * LD + GAF + dir * 16;
            const u32x4 g0 = *(const u32x4*)ga, g1 = *(const u32x4*)(ga + 8);
            float x = gb;
            x += gw[0] * bflo(g0.x) + gw[1] * bfhi(g0.x) + gw[2] * bflo(g0.y) + gw[3] * bfhi(g0.y) + gw[4] * bflo(g0.z) + gw[5] * bfhi(g0.z) + gw[6] * bflo(g0.w) + gw[7] * bfhi(g0.w);
            x += gw[8] * bflo(g1.x) + gw[9] * bfhi(g1.x) + gw[10] * bflo(g1.y) + gw[11] * bfhi(g1.y) + gw[12] * bflo(g1.z) + gw[13] * bfhi(g1.z) + gw[14] * bflo(g1.w) + gw[15] * bfhi(g1.w);
            cum[(dir * 64 + i) * 64 + k] = logsigmoidf(x) * (1.0f / 16.0f); }
    } else {
        const float lg = logsigmoidf(a.decay_logit[(L * 2 + dir) * 4 + (hl - 4)]);
#pragma unroll 4
        for (int it = 0; it < 16; ++it) cum[(dir * 64 + isub + 4 * it) * 64 + k] = lg;
    }
    __syncthreads();
    if (tid < 128) { const int d = tid >> 6; float run = 0.f;
        if (d == 0) {
#pragma unroll 8
            for (int i = 0; i < 64; ++i) { run += cum[i * 64 + k]; cum[i * 64 + k] = run; }
        } else {
#pragma unroll 8
            for (int i = 63; i >= 0; --i) { run += cum[(64 + i) * 64 + k]; cum[(64 + i) * 64 + k] = run; }
        } }
    __syncthreads();
}
__device__ __forceinline__ void load_qk16(const Args& a, const bf16_t* __restrict__ src, int hl, int pos, int g, float (&va)[8], float (&vb)[8]) {
    const u32x4 wa = *(const u32x4*)(src + g * 8), wb = *(const u32x4*)(src + 32 + g * 8);
    va[0] = bflo(wa.x); va[1] = bfhi(wa.x); va[2] = bflo(wa.y); va[3] = bfhi(wa.y); va[4] = bflo(wa.z); va[5] = bfhi(wa.z); va[6] = bflo(wa.w); va[7] = bfhi(wa.w);
    vb[0] = bflo(wb.x); vb[1] = bfhi(wb.x); vb[2] = bflo(wb.y); vb[3] = bfhi(wb.y); vb[4] = bflo(wb.z); vb[5] = bfhi(wb.z); vb[6] = bflo(wb.w); vb[7] = bfhi(wb.w);
    if (hl >= 4) { const f32x2* rp = (const f32x2*)(a.ws + WS_ROPE) + pos * 32 + g * 8;
#pragma unroll
        for (int e = 0; e < 8; ++e) { const f32x2 cs = rp[e]; const float x1 = va[e], x2 = vb[e]; va[e] = x1 * cs.x - x2 * cs.y; vb[e] = x1 * cs.y + x2 * cs.x; } }
}
__device__ __forceinline__ u32x4 pack8(const float (&v)[8]) { u32x4 w; w.x = cvt_pk_bf16(v[0], v[1]); w.y = cvt_pk_bf16(v[2], v[3]); w.z = cvt_pk_bf16(v[4], v[5]); w.w = cvt_pk_bf16(v[6], v[7]); return w; }

__device__ __forceinline__ void r1_item(const Args& a, int L, int item, LAS unsigned char* lds) {
    const int tid = otid(), wid = tid >> 6, lane = tid & 63, r32 = lane & 31, hi = lane >> 5;
    const int b = item >> 9, hl = (item >> 6) & 7, c = item & 63; const long R0 = (long)b * T + c * 64;
    const bf16_t* proj = (const bf16_t*)(a.ws + WS_PROJ);
    __syncthreads();
    build_cum(a, L, hl, R0, proj, lds);
    LAS float* cum = (LAS float*)(lds + L_CUM);
    LAS bf16_t* VT = (LAS bf16_t*)(lds + L_VT); LAS bf16_t* KeT = (LAS bf16_t*)(lds + L_QK);
    if (tid < 256) { const int i = (tid >> 2) & 63, g = tid & 3; const int kcol = hl < 4 ? GK + hl * 64 : RK + (hl - 4) * 64;
        float va[8], vb[8]; load_qk16(a, proj + (R0 + i) * LD + kcol, hl, c * 64 + i, g, va, vb);
#pragma unroll
        for (int dir = 0; dir < 2; ++dir) { const int lastrow = dir == 0 ? 63 : 64;
#pragma unroll
            for (int e = 0; e < 8; ++e) { const int ka = g * 8 + e, kb = 32 + g * 8 + e;
                const float wa = __expf(cum[lastrow * 64 + ka] - cum[(dir * 64 + i) * 64 + ka]), wb = __expf(cum[lastrow * 64 + kb] - cum[(dir * 64 + i) * 64 + kb]);
                KeT[(dir * 64 + ka) * PT + i] = (bf16_t)f2bf(va[e] * wa); KeT[(dir * 64 + kb) * PT + i] = (bf16_t)f2bf(vb[e] * wb); } }
    } else { const int t2 = tid - 256, j = t2 >> 2, vg = t2 & 3; const int vcol = hl < 4 ? GV + hl * 128 : RV + (hl - 4) * 128;
        const bf16_t* vp = proj + (R0 + j) * LD + vcol + vg * 32;
#pragma unroll
        for (int q = 0; q < 4; ++q) { const u32x4 w = *(const u32x4*)(vp + q * 8); const int v0 = vg * 32 + q * 8;
            VT[(v0 + 0) * PT + j] = (bf16_t)(w.x & 0xffff); VT[(v0 + 1) * PT + j] = (bf16_t)(w.x >> 16); VT[(v0 + 2) * PT + j] = (bf16_t)(w.y & 0xffff); VT[(v0 + 3) * PT + j] = (bf16_t)(w.y >> 16);
            VT[(v0 + 4) * PT + j] = (bf16_t)(w.z & 0xffff); VT[(v0 + 5) * PT + j] = (bf16_t)(w.z >> 16); VT[(v0 + 6) * PT + j] = (bf16_t)(w.w & 0xffff); VT[(v0 + 7) * PT + j] = (bf16_t)(w.w >> 16); } }
    __syncthreads();
    { const int dir = wid >> 2, mt = wid & 3; f32x16 acc0 = f32x16{}, acc1 = f32x16{};
#pragma unroll
        for (int ks = 0; ks < 4; ++ks) { const bf16x8 av = *(const LAS bf16x8*)(VT + (mt * 32 + r32) * PT + ks * 16 + hi * 8);
            const bf16x8 b0 = *(const LAS bf16x8*)(KeT + (dir * 64 + r32) * PT + ks * 16 + hi * 8), b1 = *(const LAS bf16x8*)(KeT + (dir * 64 + 32 + r32) * PT + ks * 16 + hi * 8);
            acc0 = __builtin_amdgcn_mfma_f32_32x32x16_bf16(av, b0, acc0, 0, 0, 0); acc1 = __builtin_amdgcn_mfma_f32_32x32x16_bf16(av, b1, acc1, 0, 0, 0); }
        bf16_t* kvt = (bf16_t*)(a.ws + WS_KVT) + (size_t)seqidx(b, hl, dir, c) * 8192;
#pragma unroll
        for (int r = 0; r < 16; ++r) { const int v = mt * 32 + crow(r, hi); kvt[v * 64 + r32] = (bf16_t)f2bf(acc0[r]); kvt[v * 64 + 32 + r32] = (bf16_t)f2bf(acc1[r]); } }
    if (tid < 128) { const int dir = tid >> 6, k = tid & 63; ((float*)(a.ws + WS_DEC))[(size_t)seqidx(b, hl, dir, c) * 64 + k] = __expf(cum[(dir == 0 ? 63 : 64) * 64 + k]); }
}

__device__ __forceinline__ void scan_phase(const Args& a) {
    const bf16_t* kvt = (const bf16_t*)(a.ws + WS_KVT); const float* dec = (const float*)(a.ws + WS_DEC); bf16_t* st = (bf16_t*)(a.ws + WS_ST);
    const int tid = otid();
    for (int g = blockIdx.x * NTHR + tid; g < 32 * 4096; g += gridDim.x * NTHR) {
        const int seq = g >> 12, e2 = g & 4095, v = e2 >> 5, k2 = (e2 & 31) * 2, dir = seq & 1; float s0 = 0.f, s1 = 0.f;
#pragma unroll 8
        for (int step = 0; step < 64; ++step) { const int c = dir ? 63 - step : step; const size_t idx = (size_t)seq * 64 + c;
            const unsigned kw = *(const unsigned*)(kvt + idx * 8192 + v * 64 + k2); const f32x2 kv = (f32x2){bflo(kw), bfhi(kw)}; const f32x2 d = *(const f32x2*)(dec + idx * 64 + k2);
            *(unsigned*)(st + idx * 8192 + v * 64 + k2) = cvt_pk_bf16(s0, s1);
            s0 = d.x * s0 + kv.x; s1 = d.y * s1 + kv.y; }
    }
}

__device__ __forceinline__ void r3_item(const Args& a, int L, int item, LAS unsigned char* lds) {
    const int tid = otid(), wid = tid >> 6, lane = tid & 63, r32 = lane & 31, hi = lane >> 5;
    const int b = item >> 9, hl = (item >> 6) & 7, c = item & 63; const long R0 = (long)b * T + c * 64;
    const bf16_t* proj = (const bf16_t*)(a.ws + WS_PROJ);
    __syncthreads();
    build_cum(a, L, hl, R0, proj, lds);
    LAS float* cum = (LAS float*)(lds + L_CUM);
    LAS bf16_t* VT = (LAS bf16_t*)(lds + L_VT); LAS bf16_t* QK = (LAS bf16_t*)(lds + L_QK);
    LAS bf16_t* P = (LAS bf16_t*)(lds + L_P);
    { const int mat = tid >> 8, i = (tid >> 2) & 63, g = tid & 3;
        const int col = mat == 0 ? (hl < 4 ? GQ + hl * 64 : RQ + (hl - 4) * 64) : (hl < 4 ? GK + hl * 64 : RK + (hl - 4) * 64);
        float va[8], vb[8]; load_qk16(a, proj + (R0 + i) * LD + col, hl, c * 64 + i, g, va, vb);
        const float sg = mat == 0 ? 1.f : -1.f;
#pragma unroll
        for (int dir = 0; dir < 2; ++dir) { float ta[8], tb[8];
#pragma unroll
            for (int e = 0; e < 8; ++e) { ta[e] = va[e] * __expf(sg * cum[(dir * 64 + i) * 64 + g * 8 + e]); tb[e] = vb[e] * __expf(sg * cum[(dir * 64 + i) * 64 + 32 + g * 8 + e]); }
            LAS bf16_t* dst = QK + ((dir * 2 + mat) * 64 + i) * PT;
            *(LAS u32x4*)(dst + g * 8) = pack8(ta); *(LAS u32x4*)(dst + 32 + g * 8) = pack8(tb); } }
    { const int j = tid >> 3, vg = tid & 7; const int vcol = hl < 4 ? GV + hl * 128 : RV + (hl - 4) * 128;
        const bf16_t* vp = proj + (R0 + j) * LD + vcol + vg * 16;
#pragma unroll
        for (int q = 0; q < 2; ++q) { const u32x4 w = *(const u32x4*)(vp + q * 8); const int v0 = vg * 16 + q * 8;
            VT[(v0 + 0) * PT + j] = (bf16_t)(w.x & 0xffff); VT[(v0 + 1) * PT + j] = (bf16_t)(w.x >> 16); VT[(v0 + 2) * PT + j] = (bf16_t)(w.y & 0xffff); VT[(v0 + 3) * PT + j] = (bf16_t)(w.y >> 16);
            VT[(v0 + 4) * PT + j] = (bf16_t)(w.z & 0xffff); VT[(v0 + 5) * PT + j] = (bf16_t)(w.z >> 16); VT[(v0 + 6) * PT + j] = (bf16_t)(w.w & 0xffff); VT[(v0 + 7) * PT + j] = (bf16_t)(w.w >> 16); } }
    __syncthreads();
    { const int dir = wid >> 2, it = (wid >> 1) & 1, jt = wid & 1; f32x16 sc = f32x16{};
        const LAS bf16_t* Qt = QK + ((dir * 2 + 0) * 64) * PT; const LAS bf16_t* Kt = QK + ((dir * 2 + 1) * 64) * PT;
#pragma unroll
        for (int ks = 0; ks < 4; ++ks) { const bf16x8 av = *(const LAS bf16x8*)(Kt + (jt * 32 + r32) * PT + ks * 16 + hi * 8), bv = *(const LAS bf16x8*)(Qt + (it * 32 + r32) * PT + ks * 16 + hi * 8);
            sc = __builtin_amdgcn_mfma_f32_32x32x16_bf16(av, bv, sc, 0, 0, 0); }
        const int i = it * 32 + r32;
#pragma unroll
        for (int g4 = 0; g4 < 4; ++g4) { float v[4];
#pragma unroll
            for (int e = 0; e < 4; ++e) { const int j = jt * 32 + 8 * g4 + 4 * hi + e; const bool keep = dir == 0 ? (j <= i) : (j >= i); v[e] = keep ? sc[g4 * 4 + e] : 0.f; }
            u32x2 w; w.x = cvt_pk_bf16(v[0], v[1]); w.y = cvt_pk_bf16(v[2], v[3]);
            *(LAS u32x2*)(P + (dir * 64 + i) * PT + jt * 32 + 8 * g4 + 4 * hi) = w; } }
    __syncthreads();
    { const int it = wid >> 2, vt = wid & 3; f32x16 acc = f32x16{};
        bf16x8 stf[2][4];
#pragma unroll
        for (int dir = 0; dir < 2; ++dir) { const bf16_t* stp = (const bf16_t*)(a.ws + WS_ST) + (size_t)seqidx(b, hl, dir, c) * 8192 + (vt * 32 + r32) * 64 + hi * 8;
#pragma unroll
            for (int ks = 0; ks < 4; ++ks) stf[dir][ks] = *(const bf16x8*)(stp + ks * 16); }
#pragma unroll
        for (int dir = 0; dir < 2; ++dir) { const LAS bf16_t* Qt = QK + ((dir * 2 + 0) * 64) * PT;
#pragma unroll
            for (int ks = 0; ks < 4; ++ks) { const bf16x8 av = *(const LAS bf16x8*)(P + (dir * 64 + it * 32 + r32) * PT + ks * 16 + hi * 8), bv = *(const LAS bf16x8*)(VT + (vt * 32 + r32) * PT + ks * 16 + hi * 8);
                acc = __builtin_amdgcn_mfma_f32_32x32x16_bf16(av, bv, acc, 0, 0, 0); }
#pragma unroll
            for (int ks = 0; ks < 4; ++ks) { const bf16x8 av = *(const LAS bf16x8*)(Qt + (it * 32 + r32) * PT + ks * 16 + hi * 8), bv = stf[dir][ks];
                acc = __builtin_amdgcn_mfma_f32_32x32x16_bf16(av, bv, acc, 0, 0, 0); } }
        __syncthreads();
        LAS float* OL = (LAS float*)(lds + L_OL);
#pragma unroll
        for (int r = 0; r < 16; ++r) OL[(it * 32 + crow(r, hi)) * OLP + vt * 32 + r32] = acc[r]; }
    __syncthreads();
    { const int row = tid >> 3, seg = tid & 7; const LAS float* op = (const LAS float*)(lds + L_OL) + row * OLP + seg * 16; float ov[16]; float s = 0.f;
#pragma unroll
        for (int e = 0; e < 16; ++e) { ov[e] = op[e]; s += ov[e] * ov[e]; }
        s += __shfl_xor(s, 1); s += __shfl_xor(s, 2); s += __shfl_xor(s, 4);
        const float rs = rsqrtf(s * (1.0f / 128.0f) + EPS);
        const int gcol = (hl < 4 ? GR + hl * 128 : RG + (hl - 4) * 128) + seg * 16;
        const bf16_t* gp = proj + (R0 + row) * LD + gcol; const u32x4 g0 = *(const u32x4*)gp, g1 = *(const u32x4*)(gp + 8);
        float gt[16] = {bflo(g0.x), bfhi(g0.x), bflo(g0.y), bfhi(g0.y), bflo(g0.z), bfhi(g0.z), bflo(g0.w), bfhi(g0.w), bflo(g1.x), bfhi(g1.x), bflo(g1.y), bfhi(g1.y), bflo(g1.z), bfhi(g1.z), bflo(g1.w), bfhi(g1.w)};
        const float* hg = a.head_gain + (size_t)L * D + 1024 + hl * 128 + seg * 16;
        float res[16];
#pragma unroll
        for (int e = 0; e < 16; ++e) res[e] = ov[e] * rs * hg[e] * siluf(gt[e]);
        bf16_t* mp = (bf16_t*)(a.ws + WS_MRG) + (R0 + row) * D + 1024 + hl * 128 + seg * 16;
        u32x4 w0, w1; w0.x = cvt_pk_bf16(res[0], res[1]); w0.y = cvt_pk_bf16(res[2], res[3]); w0.z = cvt_pk_bf16(res[4], res[5]); w0.w = cvt_pk_bf16(res[6], res[7]);
        w1.x = cvt_pk_bf16(res[8], res[9]); w1.y = cvt_pk_bf16(res[10], res[11]); w1.z = cvt_pk_bf16(res[12], res[13]); w1.w = cvt_pk_bf16(res[14], res[15]);
        *(u32x4*)mp = w0; *(u32x4*)(mp + 8) = w1; }
}
}

__device__ __forceinline__ void unpack8(const u32x4 w, float (&v)[8]) { v[0] = bflo(w.x); v[1] = bfhi(w.x); v[2] = bflo(w.y); v[3] = bfhi(w.y); v[4] = bflo(w.z); v[5] = bfhi(w.z); v[6] = bflo(w.w); v[7] = bfhi(w.w); }
__device__ __forceinline__ void conv_fix_panel(const Args& a, int L, int pm) {
    const float* HB = (const float*)(a.ws + WS_U); bf16_t* act = (bf16_t*)(a.ws + WS_ACT);
    const float* cw = a.conv_w + (size_t)L * 3 * UPW;
    const int tid = otid(); constexpr int NTN = UPW / 256, NB = 11;
#pragma unroll 1
    for (int h = 0; h < 2; ++h) {
        float pa[NB], pg[NB], na[NB], ng[NB], wa[NB], wg[NB];
#pragma unroll
        for (int k = 0; k < NB; ++k) { const int idx = tid + (h * NB + k) * NTHR;
            const int side = idx >= DFF ? 1 : 0, ch = idx - side * DFF, pn = ch >> 7, lc = ch & 127, tile = pm * NTN + pn;
            const float* hb = HB + (size_t)tile * 1024;
            pa[k] = hb[(2 + side) * 256 + lc]; pg[k] = hb[(2 + side) * 256 + 128 + lc];
            const bool has = side == 0 ? (pm & 15) != 0 : (pm & 15) != 15;
            const float* nb = side == 0 ? HB + (size_t)(tile - NTN) * 1024 + 256 : HB + (size_t)(tile + NTN) * 1024;
            na[k] = has ? nb[lc] : 0.f; ng[k] = has ? nb[128 + lc] : 0.f;
            wa[k] = cw[(side ? 2 * UPW : 0) + ch]; wg[k] = cw[(side ? 2 * UPW : 0) + DFF + ch]; }
#pragma unroll
        for (int k = 0; k < NB; ++k) { const int idx = tid + (h * NB + k) * NTHR; const int side = idx >= DFF ? 1 : 0, ch = idx - side * DFF;
            const float va = pa[k] + wa[k] * na[k], vg = pg[k] + wg[k] * ng[k];
            act[(size_t)(pm * 256 + (side ? 255 : 0)) * DFF + ch] = (bf16_t)f2bf(va * siluf(vg)); }
    }
}

__device__ __forceinline__ void final_phase(const Args& a) {
    const int tid = otid(); const int lane = tid & 63, gw = blockIdx.x * NWAVE + (tid >> 6), NGW = gridDim.x * NWAVE;
    const u64_t* ss = (const u64_t*)(a.ws + WS_SS) + 8 * M;
    for (int m = gw; m < M; m += NGW) { const float rs = ss_rstd(ss, m); f32x4* xr = (f32x4*)(a.out + (size_t)m * D) + lane; const f32x4* gp = (const f32x4*)a.final_g + lane;
#pragma unroll
        for (int j = 0; j < 8; ++j) { const f32x4 v = xr[64 * j]; xr[64 * j] = v * rs * gp[64 * j]; } }
}


__device__ __forceinline__ void inproj_strip(const bf16_t* __restrict__ xb, const bf16_t* __restrict__ wt, const u64_t* ss, bf16_t* proj, int G, int bx, LAS unsigned char* lds) {
    const int tid = otid(), wid = tid >> 6, lane = tid & 63, r32 = lane & 31, hi = lane >> 5;
    LAS float* red = (LAS float*)lds;
    for (int rb = bx; rb < M / 32; rb += G) {
        const bf16_t* ap = xb + (size_t)(rb * 32 + r32) * D + wid * 256 + hi * 8;
        const bf16_t* bp = wt + (size_t)(GAF + r32) * D + wid * 256 + hi * 8;
        f32x16 acc = f32x16{};
#pragma unroll
        for (int ks = 0; ks < 16; ++ks) { const bf16x8 av = *(const bf16x8*)(ap + ks * 16), bv = *(const bf16x8*)(bp + ks * 16);
            acc = __builtin_amdgcn_mfma_f32_32x32x16_bf16(av, bv, acc, 0, 0, 0); }
        __syncthreads();
#pragma unroll
        for (int r = 0; r < 16; ++r) red[(wid * 32 + ((r & 3) + 8 * (r >> 2) + 4 * hi)) * 33 + r32] = acc[r];
        __syncthreads();
        for (int o = tid; o < 1024; o += NTHR) { const int row = o >> 5, col = o & 31; float v = 0.f;
#pragma unroll
            for (int w = 0; w < 8; ++w) v += red[(w * 32 + row) * 33 + col];
            proj[(size_t)(rb * 32 + row) * INP + GAF + col] = (bf16_t)f2bf(v * ss_rstd(ss, rb * 32 + row)); }
    }
    __syncthreads();
}

#define XB_TMO      128
#define XB_XCNT(j)  (256  + 64 * (j))
#define XB_XSUB(j)  (1280 + 64 * (j))
#define XB_XGEN(j)  (2304 + 64 * (j))
#define XB_TOP      3328
#define XB_TOPGEN   3392
#define XCD_BAR_WORDS 3456
#define XB_SPIN_CAP (1u << 18)
__device__ __forceinline__ unsigned xb_ld(unsigned* p)              { return __hip_atomic_load(p, __ATOMIC_RELAXED, __HIP_MEMORY_SCOPE_AGENT); }
__device__ __forceinline__ unsigned xb_add(unsigned* p, unsigned v) { return __hip_atomic_fetch_add(p, v, __ATOMIC_RELAXED, __HIP_MEMORY_SCOPE_AGENT); }
__device__ __forceinline__ unsigned xb_xcc_id() { return (unsigned)__builtin_amdgcn_s_getreg((3 << 11) | 20) & 0xFu; }
#define XB_SPIN(cond, bar) do { unsigned _sp = 0; while (cond) { __builtin_amdgcn_s_sleep(1); \
    if ((++_sp & 255u) == 0u) { if (xb_ld(&(bar)[XB_TMO])) break; if (_sp > XB_SPIN_CAP) { atomicAdd(&(bar)[XB_TMO], 1u); break; } } } } while (0)
struct XcdBarrier { unsigned* bar; unsigned x; volatile LAS unsigned* st; };
__device__ __forceinline__ XcdBarrier xcd_barrier_post(unsigned* bar, volatile LAS unsigned* st) {
    XcdBarrier b; b.bar = bar; b.x = xb_xcc_id(); b.st = st;
    if (threadIdx.x == 0) (void)xb_add(&bar[XB_XCNT(b.x)], 1u);
    return b;
}
__device__ __forceinline__ void xcd_barrier_complete(unsigned* bar, unsigned x, unsigned& nloc, unsigned& nx) {
    const unsigned G = gridDim.x * gridDim.y * gridDim.z;
    unsigned sum, cnt, mine, sp = 0u;
    for (;;) {
        sum = 0u; cnt = 0u; mine = 0u;
#pragma unroll
        for (unsigned j = 0; j < 16; ++j) { const unsigned c = xb_ld(&bar[XB_XCNT(j)]); sum += c; cnt += (c > 0u) ? 1u : 0u; mine = (j == x) ? c : mine; }
        if (sum == G) break;
        __builtin_amdgcn_s_sleep(1);
        if ((++sp & 255u) == 0u) { if (xb_ld(&bar[XB_TMO])) break; if (sp > XB_SPIN_CAP) { atomicAdd(&bar[XB_TMO], 1u); break; } }
    }
    nloc = mine > 0u ? mine : 1u; nx = cnt > 0u ? cnt : 1u;
}
__device__ __forceinline__ void xcd_barrier(const XcdBarrier& b) {
    asm volatile("s_waitcnt vmcnt(0)" ::: "memory");
    __syncthreads();
    if (threadIdx.x == 0) {
        unsigned* bar = b.bar;
        __builtin_amdgcn_s_waitcnt(0);
        unsigned nloc = b.st[0], nx = b.st[1];
        if (nloc == 0u) { xcd_barrier_complete(bar, b.x, nloc, nx); b.st[0] = nloc; b.st[1] = nx; }
        const unsigned old = xb_add(&bar[XB_XSUB(b.x)], 1u);
        const unsigned gen = old / nloc;
        if (old + 1u == (gen + 1u) * nloc) {
            __builtin_amdgcn_fence(__ATOMIC_RELEASE, "agent");
            asm volatile("s_waitcnt vmcnt(0)" ::: "memory");
            const unsigned og = xb_add(&bar[XB_TOP], 1u);
            const unsigned tg = og / nx;
            if (og + 1u == (tg + 1u) * nx) xb_add(&bar[XB_TOPGEN], 1u);
            else XB_SPIN(xb_ld(&bar[XB_TOPGEN]) == tg, bar);
            __builtin_amdgcn_fence(__ATOMIC_ACQUIRE, "agent");
            xb_add(&bar[XB_XGEN(b.x)], 1u);
            asm volatile("s_waitcnt vmcnt(0)" ::: "memory");
        } else {
            XB_SPIN(xb_ld(&bar[XB_XGEN(b.x)]) == gen, bar);
            __builtin_amdgcn_fence(__ATOMIC_ACQUIRE, "agent");
            asm volatile("s_waitcnt vmcnt(0)" ::: "memory");
        }
    }
    __syncthreads();
}

constexpr int N_PHASES = 2 + 8 * DEPTH;
#ifndef GEMM_ALIGN
#define GEMM_ALIGN true
#endif
__global__ void __launch_bounds__(NTHR, 2) mega_fwd(Args a0) {
    extern __shared__ __attribute__((aligned(16))) unsigned char lds_raw[];
    LAS unsigned char* lds = (LAS unsigned char*)lds_raw;
    volatile LAS unsigned* MISC = (volatile LAS unsigned*)(lds + 131072);
    if (threadIdx.x < 32) MISC[threadIdx.x] = 0u;
    if (threadIdx.x < 256) ((LAS float*)(lds + 131072 + 256))[8 * 256 + threadIdx.x] = 0.f;
    __syncthreads();
    XcdBarrier gbar; gbar.bar = (unsigned*)(a0.ws + WS_BAR); gbar.x = 0; gbar.st = MISC + 8;
    if (a0.ph_hi - a0.ph_lo > 1) gbar = xcd_barrier_post((unsigned*)(a0.ws + WS_BAR), MISC + 8);
    bool first_sync = true;
#define GRID_SYNC() do { if (first_sync) { cg::this_grid().sync(); first_sync = false; } else xcd_barrier(gbar); } while (0)
    for (int ph = a0.ph_lo; ph < a0.ph_hi; ++ph) {
      int G = gridDim.x, bx = blockIdx.x; asm volatile("" : "+s"(G), "+s"(bx));
      const int vcu = (G % 8 == 0) ? (bx % 8) * (G / 8) + bx / 8 : bx;
      Args a = a0; asm volatile("" : "+s"(a.ws), "+s"(a.out), "+s"(a.x), "+s"(a.ln1_g), "+s"(a.w_in), "+s"(a.diff_lambda), "+s"(a.rel_bias), "+s"(a.gate_w), "+s"(a.gate_b), "+s"(a.decay_logit), "+s"(a.head_gain), "+s"(a.w_o), "+s"(a.ln2_g), "+s"(a.w_up), "+s"(a.conv_w), "+s"(a.conv_b), "+s"(a.w_down), "+s"(a.final_g));
      u64_t* ssb = (u64_t*)(a.ws + WS_SS);
      bf16_t* xb = (bf16_t*)(a.ws + WS_XB); bf16_t* proj = (bf16_t*)(a.ws + WS_PROJ); bf16_t* mrg = (bf16_t*)(a.ws + WS_MRG); bf16_t* actb = (bf16_t*)(a.ws + WS_ACT);
      const int sub_ = (ph == 0) ? 100 : (ph == N_PHASES - 1 ? 101 : ((ph - 1) & 7));
      const int nrep = (PROBE_SUB >= 0 && (sub_ == PROBE_SUB || (sub_ == 1 && (PROBE_SUB == 11 || PROBE_SUB == 12)))) ? 2 : 1;
      if (sub_ == 6) continue;
      for (int rep = 0; rep < nrep; ++rep) {
        if (rep) GRID_SYNC();
        if (ph == 0) {
#ifndef NO_PRO
 phase_prologue(a, lds);
#endif
 }
        else if (ph == N_PHASES - 1) { final_phase(a); }
        else {
            const int L = (ph - 1) >> 3, sub = (ph - 1) & 7;
            const unsigned char* wl = a.ws + WS_W + (size_t)L * W_LAYER;
            if (sub == 0) {
                inproj_strip(xb, (const bf16_t*)(wl + W_IN), ssb + (2 * L) * M, proj, G, bx, lds);
                pg8::Gemm g{xb, (const bf16_t*)(wl + W_IN), M, NGEMM_IN, D}; pg8::StaticOrder S; S.init(M, NGEMM_IN, G, bx);
                pg8::EpiScaleBf16 E{proj, INP, ssb + (2 * L) * M};
#if !defined(NO_GEMM) && !defined(NO_GEMM_A)
                pg8::gemm_phase<pg8::EpiScaleBf16, pg8::StaticOrder, GEMM_ALIGN, true>(lds, g, S, E);
#endif
            } else if (sub == 5) {
                pg8::Gemm g{xb, (const bf16_t*)(wl + W_UP), M, UPW, D}; pg8::StaticOrder S; S.init(M, UPW, G, bx);
                pg8::EpiConvGate E{actb, ssb + (2 * L + 1) * M, a.conv_w + (size_t)L * 3 * UPW, a.conv_b + (size_t)L * UPW, (float*)(a.ws + WS_U), (LAS float*)(lds + 131072 + 256)};
#if !defined(NO_GEMM) && !defined(NO_GEMM_C)
                pg8::gemm_phase<pg8::EpiConvGate, pg8::StaticOrder, true, true>(lds, g, S, E);
#endif
            } else if (sub == 4 || sub == 7) {
                const bool dn = sub == 7;
                pg8::Gemm g{dn ? actb : mrg, (const bf16_t*)(wl + (dn ? W_DN : W_O)), M, D, dn ? DFF : D}; pg8::StaticOrder S; S.init(M, D, G, bx);
                if (dn) { pg8::Unit fu; for (int i = 0; S.next(i, fu); ++i) conv_fix_panel(a, L, fu.pm);
                    asm volatile("s_waitcnt vmcnt(0)" ::: "memory"); __syncthreads(); }
                pg8::EpiResid E{a.out, xb, ssb + (2 * L + (dn ? 2 : 1)) * M};
#if !defined(NO_GEMM) && !defined(NO_GEMM_B)
                pg8::gemm_phase<pg8::EpiResid, pg8::StaticOrder, GEMM_ALIGN, true>(lds, g, S, E);
#endif
            } else if (sub == 1) {
#ifndef NO_R1
                if (!(rep && PROBE_SUB == 12)) for (int it = vcu; it < 1024; it += G) lin::r1_item(a, L, it, lds);
#endif
#ifndef NO_ATT
                const float lam = ((const float*)(a.ws + WS_LAM))[L]; const float li = 0.8f - 0.6f * __expf(-0.3f * (float)L);
                if (!(rep && PROBE_SUB == 11)) for (int u = vcu; u < 256; u += G)
                    att::attn_unit(u >> 7, (u >> 4) & 7, u & 15, proj, (const float*)(a.ws + WS_BTAB), lam, 1.0f - li, a.head_gain + (size_t)L * D,
                                   (float*)(a.ws + WS_O1) + (size_t)bx * 64 * NTHR, mrg, (LAS char*)lds);
#endif
            } else if (sub == 2) {
#ifndef NO_SCAN
                lin::scan_phase(a);
#endif
            } else if (sub == 3) {
#ifndef NO_R3
                for (int it = vcu; it < 1024; it += G) lin::r3_item(a, L, it, lds);
#endif
            }
        }
      }
        if (ph + 1 < a0.ph_hi) GRID_SYNC();
    }
}

extern "C" void kernel_launch(void* const* d_in, const int* in_sizes, int n_in, void* d_out, int out_size, void* d_ws, size_t ws_size, hipStream_t stream) {
    static int grid = 0;
    if (grid == 0) {
        if (n_in != 16 || in_sizes[0] != M * D || out_size != M * D || ws_size < WS_END) {
            fprintf(stderr, "kernel_launch: unexpected shapes (n_in %d in0 %d out %d ws %zu need %zu)\n", n_in, n_in > 0 ? in_sizes[0] : -1, out_size, ws_size, (size_t)WS_END); grid = -1; return; }
        int dev = 0, cus = 0, per_cu = 0;
        hipGetDevice(&dev); hipDeviceGetAttribute(&cus, hipDeviceAttributeMultiprocessorCount, dev);
        if (hipFuncSetAttribute((const void*)mega_fwd, hipFuncAttributeMaxDynamicSharedMemorySize, LDS_BYTES) != hipSuccess) { fprintf(stderr, "kernel_launch: hipFuncSetAttribute failed\n"); grid = -1; return; }
        if (hipOccupancyMaxActiveBlocksPerMultiprocessor(&per_cu, (const void*)mega_fwd, NTHR, LDS_BYTES) != hipSuccess || per_cu < 1) { fprintf(stderr, "kernel_launch: occupancy query says %d\n", per_cu); per_cu = 1; }
        (void)hipGetLastError();
        grid = cus * 1;
        fprintf(stderr, "kernel_launch: grid %d (cus %d, per_cu %d)\n", grid, cus, per_cu);
    }
    if (grid < 0) return;
    hipMemsetAsync((char*)d_ws + WS_SS, 0, SS_BYTES, stream);
    Args a{};
    a.x = (const float*)d_in[0]; a.ln1_g = (const float*)d_in[1]; a.w_in = (const float*)d_in[2]; a.diff_lambda = (const float*)d_in[3]; a.rel_bias = (const float*)d_in[4];
    a.gate_w = (const float*)d_in[5]; a.gate_b = (const float*)d_in[6]; a.decay_logit = (const float*)d_in[7]; a.head_gain = (const float*)d_in[8]; a.w_o = (const float*)d_in[9];
    a.ln2_g = (const float*)d_in[10]; a.w_up = (const float*)d_in[11]; a.conv_w = (const float*)d_in[12]; a.conv_b = (const float*)d_in[13]; a.w_down = (const float*)d_in[14];
    a.final_g = (const float*)d_in[15]; a.out = (float*)d_out; a.ws = (unsigned char*)d_ws;
#if MK_MULTI
    for (int ph = 0; ph < N_PHASES; ++ph) { a.ph_lo = ph; a.ph_hi = ph + 1; hipLaunchKernelGGL(mega_fwd, dim3(grid), dim3(NTHR), LDS_BYTES, stream, a); }
#else
    a.ph_lo = 0; a.ph_hi = N_PHASES;
    void* args[] = {&a};
    hipError_t e = hipLaunchCooperativeKernel((const void*)mega_fwd, dim3(grid), dim3(NTHR), args, LDS_BYTES, stream);
    if (e != hipSuccess) fprintf(stderr, "kernel_launch: cooperative launch failed: %s (grid %d)\n", hipGetErrorString(e), grid);
#endif
}
```

```cpp
#include <hip/hip_runtime.h>
#include <hip/hip_cooperative_groups.h>
#include <cstdio>
#include <cstdint>
namespace cg = cooperative_groups;

#ifndef MK_MULTI
#define MK_MULTI 0
#endif

#ifndef PROBE_SUB
#define PROBE_SUB -1
#endif
#define LAS __attribute__((address_space(3)))
typedef unsigned short bf16_t;
typedef short bf16x8 __attribute__((ext_vector_type(8)));
typedef short s16x4 __attribute__((ext_vector_type(4)));
typedef float f32x2 __attribute__((ext_vector_type(2)));
typedef float f32x4 __attribute__((ext_vector_type(4)));
typedef float f32x16 __attribute__((ext_vector_type(16)));
typedef unsigned u32x2 __attribute__((ext_vector_type(2)));
typedef unsigned u32x4 __attribute__((ext_vector_type(4)));

constexpr int NB = 2, T = 4096, M = NB * T, D = 2048, INW = 6176, INP = 6400, DFF = 5632, UPW = 2 * DFF, DEPTH = 4;
constexpr int OQ = 0, OKK = 1024, OV = 2048, GQ = 3072, GK = 3328, GV = 3584, GR = 4096, RQ = 4608, RK = 4864, RV = 5120, RG = 5632, GAF = 6144, GAB = 6160, NGEMM_IN = 6144;
constexpr int SRC_GA = 4608, SRC_RK = 4896, SRC_RV = 5152;
constexpr float EPS = 1e-6f;
constexpr int NTHR = 512, NWAVE = 8;
constexpr int BTAB_N = 448, BTAB_OFF = 224;

constexpr size_t MiB = 1u << 20;
constexpr size_t WS_SS = 0;
constexpr size_t SS_BYTES = 1 * MiB;
constexpr size_t WS_BAR = 768 * 1024;
constexpr size_t WS_LAM = 1 * MiB;
constexpr size_t WS_BTAB = 1 * MiB + 4096;
constexpr size_t WS_ROPE = 2 * MiB;
constexpr size_t WS_W = 3 * MiB;
constexpr size_t W_IN = 0, W_O = 25 * MiB, W_UP = 33 * MiB, W_DN = 77 * MiB, W_LAYER = 99 * MiB;
constexpr size_t WS_XB = WS_W + 4 * W_LAYER;
constexpr size_t WS_PROJ = WS_XB + 32 * MiB;
constexpr size_t WS_MRG = WS_PROJ + 100 * MiB;
constexpr size_t WS_U = WS_MRG + 32 * MiB;
constexpr size_t WS_ACT = WS_U + 176 * MiB;
constexpr size_t WS_KVT = WS_ACT + 88 * MiB;
constexpr size_t WS_ST = WS_KVT + 64 * MiB;
constexpr size_t WS_DEC = WS_ST + 32 * MiB;
constexpr size_t WS_O1 = WS_DEC + 1 * MiB;
constexpr size_t WS_END = WS_O1 + 32 * MiB;

constexpr int LDS_BYTES = 131072 + 256 + 11 * 1024 + 512 * 16 + 4096;

__device__ __forceinline__ unsigned cvt_pk_bf16(float lo, float hi) { unsigned r; asm volatile("v_cvt_pk_bf16_f32 %0, %1, %2" : "=v"(r) : "v"(lo), "v"(hi)); return r; }
__device__ __forceinline__ unsigned f2bf(float f) { unsigned u = __builtin_bit_cast(unsigned, f); return (u + 0x7fffu + ((u >> 16) & 1u)) >> 16; }
__device__ __forceinline__ float bf2f(unsigned short h) { return __builtin_bit_cast(float, (unsigned)h << 16); }
__device__ __forceinline__ float bflo(unsigned w) { return __builtin_bit_cast(float, w << 16); }
__device__ __forceinline__ float bfhi(unsigned w) { return __builtin_bit_cast(float, w & 0xffff0000u); }
__device__ __forceinline__ float logsigmoidf(float x) { return fminf(x, 0.f) - __logf(1.f + __expf(-fabsf(x))); }
__device__ __forceinline__ float siluf(float x) { return x * __builtin_amdgcn_rcpf(1.f + __expf(-x)); }
__device__ __forceinline__ float wave_sum(float v) {
#pragma unroll
    for (int o = 1; o < 64; o <<= 1) v += __shfl_xor(v, o);
    return v;
}
#define LDS_WAIT() asm volatile("s_waitcnt lgkmcnt(0)" ::: "memory")
typedef unsigned long long u64_t;
constexpr float SS_FX = 16777216.0f, SS_IFX = 1.0f / 16777216.0f;
__device__ __forceinline__ float ss_rstd(const u64_t* ss, int row) { return __builtin_amdgcn_rsqf((float)ss[row] * (SS_IFX / (float)2048) + 1e-6f); }
__device__ __forceinline__ int otid() { int t = threadIdx.x; asm volatile("" : "+v"(t)); return t; }

namespace pg8 {
constexpr int BM = 256, BK = 64, HALF = 128, HTB = HALF * BK * 2, STAGE_BYTES = 8 * HTB, NXCD = 8, WGM = 4;
__host__ __device__ __forceinline__ int lds_byte(int r, int c) { const int st = (r >> 4) * 2 + (c >> 5), rr = r & 15, cc = c & 31, ob = rr * 64 + cc * 2; return st * 1024 + (ob ^ (((ob >> 9) & 1) << 5)); }
__host__ __device__ __forceinline__ void stage_rc(int b, int& R, int& C) { const int st = b / 1024, sb = b % 1024, swz = sb ^ (((sb >> 9) & 1) << 5); R = (st >> 1) * 16 + swz / 64; C = (st & 1) * 32 + (swz % 64) / 2; }
__host__ __device__ __forceinline__ int perm32(int rho) { const int n = rho >> 4, i = rho & 15; return 8 * (i >> 2) + 4 * n + (i & 3); }
struct Unit { int pm, pn; };
struct Gemm { const bf16_t* A; const bf16_t* Bt; int M, N, K; };
struct StaticOrder {
    int nM, nN, nwg, G, c, wgm;
    __host__ __device__ void init(int M_, int N_, int G_, int c_, int wgm_ = WGM) { nM = M_ / BM; nN = N_ / BM; nwg = nM * nN; G = G_; c = c_; wgm = wgm_; }
    __host__ __device__ bool next(int i, Unit& u) const {
        const long L = (long)i * G + c; if (L >= nwg) return false;
        int wgid = (int)L; { const int q = nwg / NXCD, r = nwg % NXCD, xcd = wgid % NXCD, off = wgid / NXCD; wgid = (xcd < r ? xcd * (q + 1) : r * (q + 1) + (xcd - r) * q) + off; }
        const int nig = wgm * nN, gid = wgid / nig, fm = gid * wgm, gsz = (nM - fm) < wgm ? (nM - fm) : wgm;
        u.pm = fm + ((wgid % nig) % gsz); u.pn = (wgid % nig) / gsz; return true;
    }
    __device__ __forceinline__ void a_ready(const Unit&) const {}
    __device__ __forceinline__ void done(const Unit&) const {}
};

struct EpiScaleBf16 {
    static constexpr bool PERM = true, AFTER_DRAIN = false;
    bf16_t* O; int ldc; const u64_t* ss;
    __device__ __forceinline__ void operator()(const f32x4 (&acc)[2][2][4][2], const Unit& u, int wr, int wc, int fr, int fq) const {
        const int row0 = u.pm * BM + wr * 64 + fr, col0 = u.pn * BM + wc * 32 + 8 * fq;
#pragma unroll
        for (int ai = 0; ai < 2; ++ai)
#pragma unroll
            for (int m = 0; m < 4; ++m) {
                const int row = row0 + ai * HALF + m * 16;
                const float sc = ss_rstd(ss, row);
                bf16_t* rowp = O + (size_t)row * ldc + col0;
#pragma unroll
                for (int bj = 0; bj < 2; ++bj) { const f32x4 v0 = acc[ai][bj][m][0] * sc, v1 = acc[ai][bj][m][1] * sc;
                    u32x4 w; w.x = cvt_pk_bf16(v0[0], v0[1]); w.y = cvt_pk_bf16(v0[2], v0[3]); w.z = cvt_pk_bf16(v1[0], v1[1]); w.w = cvt_pk_bf16(v1[2], v1[3]);
                    *(u32x4*)(rowp + bj * HALF) = w; }
                asm volatile("" ::: "memory");
            }
    }
};

#define DPPF(old, src, ctrl) __builtin_bit_cast(float, __builtin_amdgcn_update_dpp(__builtin_bit_cast(int, (float)(old)), __builtin_bit_cast(int, (float)(src)), (ctrl), 0xf, 0xf, false))
__device__ __forceinline__ f32x4 dpp4_shr1(f32x4 o, f32x4 v) { return (f32x4){DPPF(o[0], v[0], 0x111), DPPF(o[1], v[1], 0x111), DPPF(o[2], v[2], 0x111), DPPF(o[3], v[3], 0x111)}; }
__device__ __forceinline__ f32x4 dpp4_shl1(f32x4 o, f32x4 v) { return (f32x4){DPPF(o[0], v[0], 0x101), DPPF(o[1], v[1], 0x101), DPPF(o[2], v[2], 0x101), DPPF(o[3], v[3], 0x101)}; }
__device__ __forceinline__ f32x4 dpp4_ror1(f32x4 v) { return (f32x4){DPPF(v[0], v[0], 0x121), DPPF(v[1], v[1], 0x121), DPPF(v[2], v[2], 0x121), DPPF(v[3], v[3], 0x121)}; }
__device__ __forceinline__ f32x4 dpp4_ror15(f32x4 v) { return (f32x4){DPPF(v[0], v[0], 0x12f), DPPF(v[1], v[1], 0x12f), DPPF(v[2], v[2], 0x12f), DPPF(v[3], v[3], 0x12f)}; }
struct EpiConvGate {
    static constexpr bool PERM = true, AFTER_DRAIN = false;
    bf16_t* ACT; const u64_t* ss; const float* cw; const float* cb; float* HB; LAS float* HL;
    __device__ __forceinline__ void operator()(f32x4 (&acc)[2][2][4][2], const Unit& u, int wr, int wc, int fr_in, int fq_in) const {
        int fr = fr_in, fq = fq_in; asm volatile("" : "+v"(fr), "+v"(fq));
        const int wv = wr * 4 + wc;
        LAS float* PAL = HL + 9 * 256; LAS float* DMP = HL + 11 * 256 + (wv * 64 + fq * 16 + fr) * 4; LAS float* WL = HL + 11 * 256 + 512 * 4;
        if (wv < 4) { const int cl = wv * 64 + fq * 16 + fr, ch = ((cl >> 7) ? DFF : 0) + u.pn * 128 + (cl & 127);
            WL[cl] = cw[ch]; WL[256 + cl] = cw[UPW + ch]; WL[512 + cl] = cw[2 * UPW + ch]; WL[768 + cl] = cb[ch]; }
#pragma unroll
        for (int ai = 0; ai < 2; ++ai)
#pragma unroll
            for (int m = 0; m < 4; ++m) { asm volatile("" : "+v"(fr)); const float sc = ss_rstd(ss, u.pm * BM + ai * HALF + wr * 64 + m * 16 + fr);
#pragma unroll
                for (int bj = 0; bj < 2; ++bj)
#pragma unroll
                    for (int n = 0; n < 2; ++n) acc[ai][bj][m][n] *= sc; }
        float* hb = HB + (size_t)(u.pm * (UPW / 256) + u.pn) * 1024;
#pragma unroll
        for (int ai = 0; ai < 2; ++ai) { const int blk = 2 * ai + wr;
            asm volatile("" : "+v"(fr), "+v"(fq)); const int lc0 = wc * 32 + 8 * fq;
#pragma unroll
            for (int bj = 0; bj < 2; ++bj)
#pragma unroll
                for (int n = 0; n < 2; ++n) {
                    LAS float* d0 = fr == 0 ? HL + (blk * 2 + 0) * 256 + bj * 128 + lc0 + 4 * n : DMP;
                    LAS float* d1 = fr == 15 ? HL + (blk * 2 + 1) * 256 + bj * 128 + lc0 + 4 * n : DMP;
                    *(LAS f32x4*)d0 = acc[ai][bj][0][n]; *(LAS f32x4*)d1 = acc[ai][bj][3][n]; }
        }
        asm volatile("s_waitcnt lgkmcnt(0)" ::: "memory"); __builtin_amdgcn_s_barrier(); asm volatile("" ::: "memory");
        if (wv == 0) { const int l4 = (fq * 16 + fr) * 4;
            *(f32x4*)(hb + l4) = *(const LAS f32x4*)(HL + l4); *(f32x4*)(hb + 256 + l4) = *(const LAS f32x4*)(HL + 7 * 256 + l4); }
#pragma unroll
        for (int ai = 0; ai < 2; ++ai) { const int blk = 2 * ai + wr;
            const int upslot = blk > 0 ? (blk - 1) * 2 + 1 : 8, dnslot = blk < 3 ? (blk + 1) * 2 : 8;
#pragma unroll
            for (int q = 0; q < 4; ++q) { const int bj = q >> 1, n = q & 1;
                asm volatile("" : "+v"(fr), "+v"(fq)); const int lc0 = wc * 32 + 8 * fq;
                const int cl = bj * 128 + lc0 + 4 * n;
                const f32x4 w0 = *(const LAS f32x4*)(WL + cl), w1 = *(const LAS f32x4*)(WL + 256 + cl), w2 = *(const LAS f32x4*)(WL + 512 + cl), bb = *(const LAS f32x4*)(WL + 768 + cl);
                f32x4 carry = *(const LAS f32x4*)(HL + upslot * 256 + bj * 128 + lc0 + 4 * n);
                const f32x4 hdn = *(const LAS f32x4*)(HL + dnslot * 256 + bj * 128 + lc0 + 4 * n);
#pragma unroll
                for (int m = 0; m < 4; ++m) { const f32x4 cur = acc[ai][bj][m][n];
                    const f32x4 up = dpp4_shr1(carry, cur);
                    const f32x4 nf = m < 3 ? dpp4_ror15(acc[ai][bj][m < 3 ? m + 1 : 3][n]) : hdn;
                    const f32x4 dn = dpp4_shl1(nf, cur);
                    carry = dpp4_ror1(cur);
                    acc[ai][bj][m][n] = w0 * up + w1 * cur + w2 * dn + bb; }
                if (ai == 0) { LAS float* d0 = ((wr == 0) & (fr == 0)) ? PAL + bj * 128 + lc0 + 4 * n : DMP; *(LAS f32x4*)d0 = acc[ai][bj][0][n]; }
                if (ai == 1) { LAS float* d1 = ((wr == 1) & (fr == 15)) ? PAL + 256 + bj * 128 + lc0 + 4 * n : DMP; *(LAS f32x4*)d1 = acc[ai][bj][3][n]; }
                asm volatile("s_waitcnt lgkmcnt(0)" ::: "memory");
            }
            asm volatile("" : "+v"(fr), "+v"(fq));
#pragma unroll
            for (int m = 0; m < 4; ++m) { const int row = u.pm * BM + ai * HALF + wr * 64 + m * 16 + fr;
                const f32x4 a0 = acc[ai][0][m][0], a1 = acc[ai][0][m][1], g0 = acc[ai][1][m][0], g1 = acc[ai][1][m][1];
                u32x4 w; w.x = cvt_pk_bf16(a0[0] * siluf(g0[0]), a0[1] * siluf(g0[1])); w.y = cvt_pk_bf16(a0[2] * siluf(g0[2]), a0[3] * siluf(g0[3]));
                w.z = cvt_pk_bf16(a1[0] * siluf(g1[0]), a1[1] * siluf(g1[1])); w.w = cvt_pk_bf16(a1[2] * siluf(g1[2]), a1[3] * siluf(g1[3]));
                *(u32x4*)(ACT + (size_t)row * DFF + u.pn * 128 + wc * 32 + 8 * fq) = w;
                asm volatile("" ::: "memory"); }
        }
        asm volatile("s_waitcnt lgkmcnt(0)" ::: "memory"); __builtin_amdgcn_s_barrier(); asm volatile("" ::: "memory");
        if (wv == 0) { const int l4 = (fq * 16 + fr) * 4;
            *(f32x4*)(hb + 512 + l4) = *(const LAS f32x4*)(PAL + l4); *(f32x4*)(hb + 768 + l4) = *(const LAS f32x4*)(PAL + 256 + l4);
            asm volatile("s_waitcnt lgkmcnt(0)" ::: "memory"); }
    }
};
struct EpiResid {
    static constexpr bool PERM = false, AFTER_DRAIN = false;
    float* X; bf16_t* XB; u64_t* ssn;
    __device__ __forceinline__ void operator()(const f32x4 (&acc)[2][2][4][2], const Unit& u, int wr, int wc, int fr, int fq) const {
        const int col0 = u.pn * BM + wc * 32 + 4 * fq;
#pragma unroll
        for (int ai = 0; ai < 2; ++ai)
#pragma unroll
            for (int m = 0; m < 4; ++m) {
                const int row = u.pm * BM + ai * HALF + wr * 64 + m * 16 + fr; const size_t off = (size_t)row * D + col0; float part = 0.f;
#pragma unroll
                for (int bj = 0; bj < 2; ++bj)
#pragma unroll
                    for (int n = 0; n < 2; ++n) { float* xp = X + off + bj * HALF + n * 16; const f32x4 xv = *(const f32x4*)xp + acc[ai][bj][m][n]; *(f32x4*)xp = xv;
                        part += (xv[0] * xv[0] + xv[1] * xv[1]) + (xv[2] * xv[2] + xv[3] * xv[3]);
                        u32x2 w; w.x = cvt_pk_bf16(xv[0], xv[1]); w.y = cvt_pk_bf16(xv[2], xv[3]); *(u32x2*)(XB + off + bj * HALF + n * 16) = w; }
                part += __shfl_xor(part, 16); part += __shfl_xor(part, 32);
                if (fq == 0) atomicAdd(ssn + row, (u64_t)(part * SS_FX + 0.5f));
                asm volatile("" ::: "memory");
            }
    }
};

template <class Epi, class Sched, bool ALIGN_EPI = false, bool SP2 = false>
__device__ __forceinline__ void gemm_phase(LAS unsigned char* lds, const Gemm g, const Sched& S, const Epi& E) {
    const int tid = otid(), wid = __builtin_amdgcn_readfirstlane(tid >> 6), lane = tid & 63, wr = wid >> 2, wc = wid & 3, fr = lane & 15, fq = lane >> 4;
    const int K = g.K, nt = K / BK;
    unsigned voffA[2], voffB[2];
#pragma unroll
    for (int i = 0; i < 2; ++i) { int R, C; stage_rc(tid * 16 + i * 8192, R, C); const int Rb = Epi::PERM ? ((R & ~31) + perm32(R & 31)) : R;
        voffA[i] = (unsigned)(R * K + C) * 2u; voffB[i] = (unsigned)(Rb * K + C) * 2u; }
    const size_t kstep = (size_t)(BK * 2);
    const size_t hstep = (size_t)HALF * K * 2;
    const size_t tstep = 2 * hstep;
    const unsigned ldsw = (unsigned)wid * 1024u;
    const int aoff = lds_byte(wr * 64 + fr, fq * 8), boff = lds_byte(wc * 32 + fr, fq * 8);
#define PG8_SA(b, h) (((b) * 2 + (h)) * HTB)
#define PG8_SB(b, h) ((4 + (b) * 2 + (h)) * HTB)
#define PG8_STAGE(bufoff, gbase, voff) do { _Pragma("unroll") for (int _i = 0; _i < 2; ++_i) \
        __builtin_amdgcn_global_load_lds((const unsigned*)((const char*)(gbase) + (voff)[_i]), (LAS unsigned*)(lds + (bufoff) + ldsw + _i * 8192), 16, 0, 0); } while (0)
#define PG8_LDA(dst, b, h) do { _Pragma("unroll") for (int m = 0; m < 4; ++m) _Pragma("unroll") for (int k = 0; k < 2; ++k) dst[m][k] = *(const LAS bf16x8*)(lds + PG8_SA(b, h) + aoff + m * 2048 + k * 1024); } while (0)
#define PG8_LDB(dst, b, h) do { _Pragma("unroll") for (int n = 0; n < 2; ++n) _Pragma("unroll") for (int k = 0; k < 2; ++k) dst[n][k] = *(const LAS bf16x8*)(lds + PG8_SB(b, h) + boff + n * 2048 + k * 1024); } while (0)
#define PG8_MMA(ai, bj, At, Bt) do { __builtin_amdgcn_s_setprio(1); _Pragma("unroll") for (int m = 0; m < 4; ++m) _Pragma("unroll") for (int n = 0; n < 2; ++n) _Pragma("unroll") for (int k = 0; k < 2; ++k) \
        acc[ai][bj][m][n] = __builtin_amdgcn_mfma_f32_16x16x32_bf16(Bt[n][k], At[m][k], acc[ai][bj][m][n], 0, 0, 0); __builtin_amdgcn_s_setprio(0); } while (0)
#define PG8_WAIT_V(n) asm volatile("s_waitcnt vmcnt(" #n ")" ::: "memory")
#define PG8_WAIT_L(n) asm volatile("s_waitcnt lgkmcnt(" #n ")" ::: "memory")
#define PG8_BAR __builtin_amdgcn_s_barrier()
#define PG8_SCHED __builtin_amdgcn_sched_barrier(0)
    Unit cur, nxt; int ui = 0;
    if (!S.next(0, cur)) return;
    f32x4 acc[2][2][4][2];
#pragma unroll
    for (int a = 0; a < 2; ++a)
#pragma unroll
        for (int b = 0; b < 2; ++b)
#pragma unroll
            for (int m = 0; m < 4; ++m)
#pragma unroll
                for (int n = 0; n < 2; ++n) acc[a][b][m][n] = (f32x4){0.f, 0.f, 0.f, 0.f};
    bf16x8 At[4][2], B0[2][2], B1[2][2];
    const char* cA = (const char*)g.A + (size_t)cur.pm * tstep; const char* cB = (const char*)g.Bt + (size_t)cur.pn * tstep;
    S.a_ready(cur);
    if constexpr (SP2) {
        PG8_STAGE(PG8_SB(0, 0), cB, voffB); PG8_STAGE(PG8_SB(0, 1), cB + hstep, voffB); PG8_STAGE(PG8_SA(0, 0), cA, voffA); PG8_STAGE(PG8_SA(0, 1), cA + hstep, voffA);
        if (wr == 1) PG8_BAR;
        PG8_WAIT_V(2); PG8_BAR;
        PG8_STAGE(PG8_SB(1, 0), cB + kstep, voffB); PG8_STAGE(PG8_SA(1, 0), cA + kstep, voffA); PG8_STAGE(PG8_SB(1, 1), cB + hstep + kstep, voffB);
        PG8_WAIT_V(6); PG8_BAR;
    } else {
        PG8_STAGE(PG8_SB(0, 0), cB, voffB); PG8_STAGE(PG8_SA(0, 0), cA, voffA); PG8_STAGE(PG8_SB(0, 1), cB + hstep, voffB); PG8_STAGE(PG8_SA(0, 1), cA + hstep, voffA);
        if (wr == 1) PG8_BAR;
        PG8_WAIT_V(4); PG8_BAR;
        PG8_STAGE(PG8_SB(1, 0), cB + kstep, voffB); PG8_STAGE(PG8_SA(1, 0), cA + kstep, voffA); PG8_STAGE(PG8_SB(1, 1), cB + hstep + kstep, voffB);
        PG8_WAIT_V(6); PG8_BAR;
    }
    for (;;) {
        const bool has_next = S.next(ui + 1, nxt);
        const char* nA = has_next ? (const char*)g.A + (size_t)nxt.pm * tstep : cA; const char* nB = has_next ? (const char*)g.Bt + (size_t)nxt.pn * tstep : cB;
        for (int t = 0; t < nt; t += 2) {
            const bool last = (t == nt - 2);
            const char* a1 = cA + (size_t)(t + 1) * kstep;
            const char* a2 = last ? nA : cA + (size_t)(t + 2) * kstep; const char* b2 = last ? nB : cB + (size_t)(t + 2) * kstep;
            const char* a3 = a2 + kstep; const char* b3 = b2 + kstep;
            if (last && has_next) S.a_ready(nxt);
            if constexpr (SP2) {
            PG8_LDB(B0, 0, 0); PG8_LDB(B1, 0, 1); PG8_SCHED; PG8_LDA(At, 0, 0); PG8_STAGE(PG8_SA(1, 1), a1 + hstep, voffA);
            PG8_WAIT_V(8); PG8_WAIT_L(0); PG8_BAR; PG8_MMA(0, 0, At, B0); PG8_MMA(0, 1, At, B1); PG8_BAR; PG8_SCHED;
            PG8_LDA(At, 0, 1); PG8_STAGE(PG8_SB(0, 0), b2, voffB); PG8_STAGE(PG8_SB(0, 1), b2 + hstep, voffB); PG8_STAGE(PG8_SA(0, 0), a2, voffA);
            PG8_WAIT_V(8); PG8_WAIT_L(0); PG8_BAR; PG8_MMA(1, 0, At, B0); PG8_MMA(1, 1, At, B1); PG8_BAR; PG8_SCHED;
            PG8_LDB(B0, 1, 0); PG8_LDB(B1, 1, 1); PG8_SCHED; PG8_LDA(At, 1, 0); PG8_STAGE(PG8_SA(0, 1), a2 + hstep, voffA);
            PG8_WAIT_V(8); PG8_WAIT_L(0); PG8_BAR; PG8_MMA(0, 0, At, B0); PG8_MMA(0, 1, At, B1); PG8_BAR; PG8_SCHED;
            PG8_LDA(At, 1, 1); PG8_STAGE(PG8_SB(1, 0), b3, voffB); PG8_STAGE(PG8_SB(1, 1), b3 + hstep, voffB); PG8_STAGE(PG8_SA(1, 0), a3, voffA);
            PG8_WAIT_V(8); PG8_WAIT_L(0); PG8_BAR; PG8_MMA(1, 0, At, B0); PG8_MMA(1, 1, At, B1); PG8_BAR; PG8_SCHED;
            } else {
            PG8_LDB(B0, 0, 0); PG8_SCHED; PG8_LDA(At, 0, 0); PG8_STAGE(PG8_SA(1, 1), a1 + hstep, voffA);
            PG8_WAIT_L(8); PG8_BAR; PG8_WAIT_L(0); PG8_MMA(0, 0, At, B0); PG8_BAR; PG8_SCHED;
            PG8_LDB(B1, 0, 1); PG8_STAGE(PG8_SB(0, 0), b2, voffB);
            PG8_BAR; PG8_WAIT_L(0); PG8_MMA(0, 1, At, B1); PG8_BAR;
            PG8_LDA(At, 0, 1); PG8_STAGE(PG8_SA(0, 0), a2, voffA);
            PG8_BAR; PG8_WAIT_L(0); PG8_MMA(1, 0, At, B0); PG8_BAR; PG8_SCHED;
            PG8_STAGE(PG8_SB(0, 1), b2 + hstep, voffB);
            PG8_WAIT_V(6); PG8_BAR; PG8_MMA(1, 1, At, B1); PG8_BAR;
            PG8_LDB(B0, 1, 0); PG8_SCHED; PG8_LDA(At, 1, 0); PG8_STAGE(PG8_SA(0, 1), a2 + hstep, voffA);
            PG8_WAIT_L(8); PG8_BAR; PG8_WAIT_L(0); PG8_MMA(0, 0, At, B0); PG8_BAR; PG8_SCHED;
            PG8_LDB(B1, 1, 1); PG8_STAGE(PG8_SB(1, 0), b3, voffB);
            PG8_BAR; PG8_WAIT_L(0); PG8_MMA(0, 1, At, B1); PG8_BAR;
            PG8_LDA(At, 1, 1); PG8_STAGE(PG8_SA(1, 0), a3, voffA);
            PG8_BAR; PG8_WAIT_L(0); PG8_MMA(1, 0, At, B0); PG8_BAR; PG8_SCHED;
            PG8_STAGE(PG8_SB(1, 1), b3 + hstep, voffB);
            PG8_WAIT_V(6); PG8_BAR; PG8_MMA(1, 1, At, B1); PG8_BAR;
            }
        }
        if constexpr (ALIGN_EPI) { if (wr == 0) PG8_BAR; }
        if constexpr (!Epi::AFTER_DRAIN) { E(acc, cur, wr, wc, fr, fq); S.done(cur); }
        if (!has_next) break;
#pragma unroll
        for (int a = 0; a < 2; ++a)
#pragma unroll
            for (int b = 0; b < 2; ++b)
#pragma unroll
                for (int m = 0; m < 4; ++m)
#pragma unroll
                    for (int n = 0; n < 2; ++n) acc[a][b][m][n] = (f32x4){0.f, 0.f, 0.f, 0.f};
        cur = nxt; cA = nA; cB = nB; ++ui;
        if constexpr (ALIGN_EPI) { if (wr == 1) PG8_BAR; }
    }
    PG8_WAIT_V(0);
    if constexpr (!ALIGN_EPI) { if (wr == 0) PG8_BAR; }
    PG8_BAR;
#undef PG8_SA
#undef PG8_SB
#undef PG8_STAGE
#undef PG8_LDA
#undef PG8_LDB
#undef PG8_MMA
#undef PG8_WAIT_V
#undef PG8_WAIT_L
#undef PG8_BAR
#undef PG8_SCHED
}
}

struct Args {
    const float* x; const float* ln1_g; const float* w_in; const float* diff_lambda; const float* rel_bias; const float* gate_w; const float* gate_b;
    const float* decay_logit; const float* head_gain; const float* w_o; const float* ln2_g; const float* w_up; const float* conv_w; const float* conv_b;
    const float* w_down; const float* final_g;
    float* out; unsigned char* ws; int ph_lo, ph_hi;
};

struct TItem { const float* src; const float* gk; bf16_t* dst; int N, K; float cs; };
__device__ __forceinline__ TItem titem_decode(const Args& a, int it) {
    constexpr int I_IN = (D / 64) * (INW / 32), I_O = (D / 64) * (D / 32), I_UP = (D / 64) * (UPW / 32), I_DN = (DFF / 64) * (D / 32), I_L = I_IN + I_O + I_UP + I_DN;
    const int L = it / I_L; int r = it % I_L; unsigned char* wl = a.ws + WS_W + (size_t)L * W_LAYER; TItem t;
    if (r < I_IN) { const int nblk = INW / 32, kb = r / nblk, n0 = (r % nblk) * 32, k0 = kb * 64;
        t.cs = ((n0 >= GQ && n0 < GK) || (n0 >= SRC_RK && n0 < SRC_RV)) ? 0.125f : 1.f; t.N = INW; t.K = D; t.src = a.w_in + (size_t)L * D * INW + (size_t)k0 * INW + n0; t.gk = a.ln1_g + L * D + k0;
        const int dn = n0 < SRC_GA ? n0 : (n0 < SRC_GA + 32 ? GAF + (n0 - SRC_GA) : n0 - 32);
        t.dst = (bf16_t*)(wl + W_IN) + (size_t)dn * D + k0; return t; }
    r -= I_IN;
    if (r < I_O) { const int nblk = D / 32, kb = r / nblk, n0 = (r % nblk) * 32, k0 = kb * 64;
        t.cs = 1.f; t.N = D; t.K = D; t.src = a.w_o + (size_t)L * D * D + (size_t)k0 * D + n0; t.gk = nullptr; t.dst = (bf16_t*)(wl + W_O) + (size_t)n0 * D + k0; return t; }
    r -= I_O;
    if (r < I_UP) { const int nblk = UPW / 32, kb = r / nblk, n0 = (r % nblk) * 32, k0 = kb * 64;
        const int c = n0 < DFF ? n0 : n0 - DFF; const int dst = (c >> 7) * 256 + (c & 127) + (n0 < DFF ? 0 : 128);
        t.cs = 1.f; t.N = UPW; t.K = D; t.src = a.w_up + (size_t)L * D * UPW + (size_t)k0 * UPW + n0; t.gk = a.ln2_g + L * D + k0; t.dst = (bf16_t*)(wl + W_UP) + (size_t)dst * D + k0; return t; }
    r -= I_UP;
    { const int nblk = D / 32, kb = r / nblk, n0 = (r % nblk) * 32, k0 = kb * 64;
        t.cs = 1.f; t.N = D; t.K = DFF; t.src = a.w_down + (size_t)L * DFF * D + (size_t)k0 * D + n0; t.gk = nullptr; t.dst = (bf16_t*)(wl + W_DN) + (size_t)n0 * DFF + k0; return t; }
}
#define TI_LOAD(R, GV, t) do { const float* sp_ = (t).src + (size_t)(lane >> 5) * (t).N + (lane & 31); \
    _Pragma("unroll") for (int i = 0; i < 32; ++i) R[i] = sp_[(size_t)(2 * i) * (t).N]; \
    if ((t).gk) { const f32x4 g0_ = *(const f32x4*)((t).gk + 8 * (lane & 7)), g1_ = *(const f32x4*)((t).gk + 8 * (lane & 7) + 4); \
        GV[0] = g0_[0] * (t).cs; GV[1] = g0_[1] * (t).cs; GV[2] = g0_[2] * (t).cs; GV[3] = g0_[3] * (t).cs; GV[4] = g1_[0] * (t).cs; GV[5] = g1_[1] * (t).cs; GV[6] = g1_[2] * (t).cs; GV[7] = g1_[3] * (t).cs; } \
    else { _Pragma("unroll") for (int e = 0; e < 8; ++e) GV[e] = (t).cs; } } while (0)
#define TI_PROC(R, GV, t) do { \
    _Pragma("unroll") for (int i = 0; i < 32; ++i) scr[(2 * i + (lane >> 5)) * 33 + (lane & 31)] = R[i]; \
    LDS_WAIT(); asm volatile("" ::: "memory"); \
    const int c_ = lane & 7; \
    _Pragma("unroll") for (int j = 0; j < 4; ++j) { const int n_ = (lane >> 3) + 8 * j; const LAS float* s_ = scr + (8 * c_) * 33 + n_; \
        u32x4 o_; o_.x = cvt_pk_bf16(s_[0 * 33] * GV[0], s_[1 * 33] * GV[1]); o_.y = cvt_pk_bf16(s_[2 * 33] * GV[2], s_[3 * 33] * GV[3]); \
        o_.z = cvt_pk_bf16(s_[4 * 33] * GV[4], s_[5 * 33] * GV[5]); o_.w = cvt_pk_bf16(s_[6 * 33] * GV[6], s_[7 * 33] * GV[7]); \
        *(u32x4*)((t).dst + (size_t)n_ * (t).K + 8 * c_) = o_; } \
    LDS_WAIT(); asm volatile("" ::: "memory"); } while (0)

__device__ __forceinline__ void phase_prologue(const Args& a, LAS unsigned char* lds) {
    const int tid = otid(), lane = tid & 63, wave = tid >> 6, G = gridDim.x;
    LAS float* scr = (LAS float*)(lds + wave * 16384);
    const int gw = blockIdx.x * NWAVE + wave, NGW = G * NWAVE;
    constexpr int I_IN = (D / 64) * (INW / 32), I_O = (D / 64) * (D / 32), I_UP = (D / 64) * (UPW / 32), I_DN = (DFF / 64) * (D / 32), I_L = I_IN + I_O + I_UP + I_DN, I_ALL = DEPTH * I_L;
    { float ra[32], rb[32], ga[8], gb[8]; TItem ta, tb;
        if (gw < I_ALL) { ta = titem_decode(a, gw); TI_LOAD(ra, ga, ta); }
        for (int it = gw; it < I_ALL; it += 2 * NGW) {
            const bool hasB = it + NGW < I_ALL;
            if (hasB) { tb = titem_decode(a, it + NGW); TI_LOAD(rb, gb, tb); }
            TI_PROC(ra, ga, ta);
            if (it + 2 * NGW < I_ALL) { ta = titem_decode(a, it + 2 * NGW); TI_LOAD(ra, ga, ta); }
            if (hasB) TI_PROC(rb, gb, tb);
        } }
    { const int gt = blockIdx.x * NTHR + tid, NT_ = G * NTHR; constexpr int PER = (INP - INW) * D * 2 / 16;
        for (int i = gt; i < DEPTH * PER; i += NT_) { const int L = i / PER, j = i % PER;
            *(u32x4*)(a.ws + WS_W + (size_t)L * W_LAYER + W_IN + (size_t)INW * D * 2 + (size_t)j * 16) = (u32x4){0u, 0u, 0u, 0u}; } }
    { u64_t* ss0 = (u64_t*)(a.ws + WS_SS); bf16_t* xb = (bf16_t*)(a.ws + WS_XB);
        for (int m = gw; m < M; m += NGW) { const f32x4* xr = (const f32x4*)(a.x + (size_t)m * D) + lane; f32x4* orow = (f32x4*)(a.out + (size_t)m * D) + lane; u32x2* brow = (u32x2*)(xb + (size_t)m * D) + lane; float s = 0.f;
#pragma unroll
            for (int j = 0; j < 8; ++j) { const f32x4 v = xr[64 * j]; orow[64 * j] = v; s += (v[0] * v[0] + v[1] * v[1]) + (v[2] * v[2] + v[3] * v[3]);
                u32x2 w; w.x = cvt_pk_bf16(v[0], v[1]); w.y = cvt_pk_bf16(v[2], v[3]); brow[64 * j] = w; }
            s = wave_sum(s); if (lane == 0) ss0[m] = (u64_t)(s * SS_FX + 0.5f); } }
    { const int gt = blockIdx.x * NTHR + tid, NT_ = G * NTHR;
        f32x2* rope = (f32x2*)(a.ws + WS_ROPE);
        for (int i = gt; i < T * 32; i += NT_) { const int pos = i >> 5, f = i & 31;
            const float ex = (float)f * (1.0f / 31.0f); const float inv = 1.0f / __builtin_amdgcn_exp2f(ex * 13.287712379549449f);
            const float ang = (float)pos * inv; const double rev = (double)ang * 0.15915494309189535; const float fr = (float)(rev - __builtin_rint(rev));
            rope[i] = (f32x2){__builtin_amdgcn_cosf(fr), __builtin_amdgcn_sinf(fr)}; }
        float* btab = (float*)(a.ws + WS_BTAB);
        for (int i = gt; i < 8 * BTAB_N; i += NT_) { const int h = i / BTAB_N, rel = i % BTAB_N - BTAB_OFF; const int n = rel < 0 ? -rel : rel;
            int bk = n; if (n >= 8) { bk = 8 + (n >= 12) + (n >= 16) + (n >= 23) + (n >= 32) + (n >= 46) + (n >= 64) + (n >= 91); }
            if (rel > 0) bk += 16; btab[i] = a.rel_bias[bk * 8 + h] * 8.0f; }
        if (gt < DEPTH) { const float* lp = a.diff_lambda + gt * 256; float s1 = 0.f, s2 = 0.f; for (int j = 0; j < 64; ++j) { s1 += lp[j] * lp[64 + j]; s2 += lp[128 + j] * lp[192 + j]; }
            float e1 = __expf(s1), e2 = __expf(s2); asm volatile("" : "+v"(e1), "+v"(e2));
            const float li = 0.8f - 0.6f * __expf(-0.3f * (float)gt); ((float*)(a.ws + WS_LAM))[gt] = (e1 - e2) + li; } }
}

namespace att {
constexpr int LD = INP;
constexpr float SCALE = 0.125f, THR = 8.f;
constexpr int SHM_V = 64 * 128 * 2, SHM_K = 64 * 64 * 2;
constexpr int NBUF = 3;
constexpr int L_V = 0, L_K = NBUF * SHM_V, L_WS = L_K + NBUF * SHM_K, L_TAB = L_WS + NWAVE * 64 * 4;
#define KSWZ64(row, colB) ((row) * 128 + ((colB) ^ ((((row) >> 1) & 7) << 4)))
#define SBAR() __builtin_amdgcn_sched_barrier(0)
__device__ __forceinline__ int crow(int r, int hi) { return (r & 3) + 8 * (r >> 2) + 4 * hi; }
#define MX3(a, b, c) __builtin_fmaxf(__builtin_fmaxf((a), (b)), (c))
__device__ __forceinline__ void partialSM(f32x16& p0, f32x16& p1, float& m_reg, float& mn, float& alpha, float boff) {
    constexpr float C = SCALE * 1.4426950408889634f;
    float a = MX3(p0[0], p0[1], p1[0]), b = MX3(p0[2], p0[3], p1[1]); a = MX3(a, p1[2], p1[3]);
#pragma unroll
    for (int r = 4; r < 16; r += 4) { a = MX3(a, p0[r], p0[r + 1]); b = MX3(b, p0[r + 2], p0[r + 3]); a = MX3(a, p1[r], p1[r + 1]); b = MX3(b, p1[r + 2], p1[r + 3]); }
    float pmax = __builtin_fmaxf(a, b);
    { auto rr = __builtin_amdgcn_permlane32_swap(__float_as_uint(pmax), __float_as_uint(pmax), false, false);
      pmax = fmaxf(__uint_as_float(rr[0]), __uint_as_float(rr[1])) + boff; }
    if (__builtin_expect(__all(pmax - m_reg <= THR / SCALE), 1)) { mn = m_reg; alpha = 1.f; }
    else { mn = fmaxf(m_reg, pmax); alpha = __builtin_amdgcn_exp2f((m_reg - mn) * C); m_reg = mn; }
    const float mnC = (boff - mn) * C;
#pragma unroll
    for (int r = 0; r < 16; ++r) p0[r] = fmaf(p0[r], C, mnC);
#pragma unroll
    for (int r = 0; r < 16; ++r) p1[r] = fmaf(p1[r], C, mnC);
#pragma unroll
    for (int r = 0; r < 16; ++r) p0[r] = __builtin_amdgcn_exp2f(p0[r]);
}
__device__ __forceinline__ void finishSM(f32x16& p0, f32x16& p1, float alpha, float& l_reg, bf16x8& pa0, bf16x8& pa1, bf16x8& pa2, bf16x8& pa3) {
#pragma unroll
    for (int r = 0; r < 16; ++r) p1[r] = __builtin_amdgcn_exp2f(p1[r]);
    float ps = 0;
#pragma unroll
    for (int r = 0; r < 16; ++r) ps += p0[r];
#pragma unroll
    for (int r = 0; r < 16; ++r) ps += p1[r];
    { auto rr = __builtin_amdgcn_permlane32_swap(__float_as_uint(ps), __float_as_uint(ps), false, false);
      ps = __uint_as_float(rr[0]) + __uint_as_float(rr[1]); }
    l_reg = l_reg * alpha + ps;
#define PK4(P, BASE, OUT) do { unsigned a0 = cvt_pk_bf16(P[BASE + 0], P[BASE + 1]), a1 = cvt_pk_bf16(P[BASE + 2], P[BASE + 3]);   \
    unsigned b0 = cvt_pk_bf16(P[BASE + 4], P[BASE + 5]), b1 = cvt_pk_bf16(P[BASE + 6], P[BASE + 7]);                              \
    auto r0 = __builtin_amdgcn_permlane32_swap(a0, b0, false, false); auto r1 = __builtin_amdgcn_permlane32_swap(a1, b1, false, false); \
    u32x4 w = {r0[0], r1[0], r0[1], r1[1]}; OUT = __builtin_bit_cast(bf16x8, w); } while (0)
    PK4(p0, 0, pa0); PK4(p0, 8, pa1); PK4(p1, 0, pa2); PK4(p1, 8, pa3);
#undef PK4
}
__device__ __forceinline__ float qkt(f32x16& p0, f32x16& p1, const LAS char* Ks, const bf16x8* qr, int r32, int hi, int dlt, float cL, float cR, const LAS float* tabL) {
    bf16x8 b0[4], b1[4];
#pragma unroll
    for (int d0 = 0; d0 < 4; ++d0) { const int cb = d0 * 32 + hi * 16;
        b0[d0] = *(const LAS bf16x8*)(Ks + KSWZ64(r32, cb)); b1[d0] = *(const LAS bf16x8*)(Ks + KSWZ64(32 + r32, cb)); }
    if (dlt <= -191 || dlt >= 159) {
        const f32x16 z = f32x16{};
        p0 = __builtin_amdgcn_mfma_f32_32x32x16_bf16(b0[0], qr[0], z, 0, 0, 0); p1 = __builtin_amdgcn_mfma_f32_32x32x16_bf16(b1[0], qr[0], z, 0, 0, 0);
#pragma unroll
        for (int d0 = 1; d0 < 4; ++d0) { p0 = __builtin_amdgcn_mfma_f32_32x32x16_bf16(b0[d0], qr[d0], p0, 0, 0, 0); p1 = __builtin_amdgcn_mfma_f32_32x32x16_bf16(b1[d0], qr[d0], p1, 0, 0, 0); }
        return dlt < 0 ? cL : cR;
    }
    const LAS float* tp = tabL + (dlt + BTAB_OFF + 4 * hi - r32);
#pragma unroll
    for (int r = 0; r < 16; ++r) { p0[r] = tp[(r & 3) + 8 * (r >> 2)]; p1[r] = tp[32 + (r & 3) + 8 * (r >> 2)]; }
    asm volatile("s_waitcnt lgkmcnt(0)" ::: "memory");
#pragma unroll
    for (int d0 = 0; d0 < 4; ++d0) { p0 = __builtin_amdgcn_mfma_f32_32x32x16_bf16(b0[d0], qr[d0], p0, 0, 0, 0); p1 = __builtin_amdgcn_mfma_f32_32x32x16_bf16(b1[d0], qr[d0], p1, 0, 0, 0); }
    return 0.f;
}
__device__ __forceinline__ int v_st(int k, int c) { const int kk = (k & ~0xC) | ((k & 4) << 1) | ((k & 8) >> 1); return ((kk >> 3) * 4 + (c >> 5)) * 512 + ((kk & 7) * 32 + (c & 31)) * 2; }
__device__ __forceinline__ int v_rd_base(int lane) { return ((lane & 3) << 3) | (((lane >> 2) & 3) << 6) | (((lane >> 4) & 1) << 5) | (((lane >> 5) & 1) << 8); }
constexpr int v_rd_off(int d0, int ks, int half) { return d0 * 512 + ks * 4096 + half * 2048; }
template <int OFF> __device__ __forceinline__ s16x4 tr_read(int vb) {
    s16x4 r; asm volatile("ds_read_b64_tr_b16 %0, %1 offset:%2" : "=&v"(r) : "v"(vb), "i"(OFF) : "memory"); return r;
}
template <int D0> __device__ __forceinline__ void pv_one(f32x16& od, int vb, bf16x8 pa0, bf16x8 pa1, bf16x8 pa2, bf16x8 pa3) {
    const s16x4 l0 = tr_read<v_rd_off(D0, 0, 0)>(vb), h0 = tr_read<v_rd_off(D0, 0, 1)>(vb), l1 = tr_read<v_rd_off(D0, 1, 0)>(vb), h1 = tr_read<v_rd_off(D0, 1, 1)>(vb);
    const s16x4 l2 = tr_read<v_rd_off(D0, 2, 0)>(vb), h2 = tr_read<v_rd_off(D0, 2, 1)>(vb), l3 = tr_read<v_rd_off(D0, 3, 0)>(vb), h3 = tr_read<v_rd_off(D0, 3, 1)>(vb);
    asm volatile("s_waitcnt lgkmcnt(0)" ::: "memory"); SBAR();
#define PK(L, H) (bf16x8){L[0], L[1], L[2], L[3], H[0], H[1], H[2], H[3]}
    od = __builtin_amdgcn_mfma_f32_32x32x16_bf16(pa0, PK(l0, h0), od, 0, 0, 0);
    od = __builtin_amdgcn_mfma_f32_32x32x16_bf16(pa1, PK(l1, h1), od, 0, 0, 0);
    od = __builtin_amdgcn_mfma_f32_32x32x16_bf16(pa2, PK(l2, h2), od, 0, 0, 0);
    od = __builtin_amdgcn_mfma_f32_32x32x16_bf16(pa3, PK(l3, h3), od, 0, 0, 0);
#undef PK
}
__device__ __forceinline__ void pv_d0(f32x16* o, int vb, bf16x8 pa0, bf16x8 pa1, bf16x8 pa2, bf16x8 pa3) {
    pv_one<0>(o[0], vb, pa0, pa1, pa2, pa3); pv_one<1>(o[1], vb, pa0, pa1, pa2, pa3); pv_one<2>(o[2], vb, pa0, pa1, pa2, pa3); pv_one<3>(o[3], vb, pa0, pa1, pa2, pa3);
}

__device__ __forceinline__ void attn_unit(int b, int h, int qb, const bf16_t* __restrict__ proj, const float* __restrict__ btab, float lam, float outscale,
                                          const float* __restrict__ gain, float* o1scr, bf16_t* merged, LAS char* lds) {
    const int tid = otid(), wid = __builtin_amdgcn_readfirstlane(tid >> 6), lane = tid & 63, r32 = lane & 31, hi = lane >> 5;
    const long rowbase = (long)b * T; const int qw = qb * 256 + wid * 32;
    LAS char* V_lds = lds + L_V; LAS char* K_lds = lds + L_K;
    LAS float* wsl = (LAS float*)(lds + L_WS) + wid * 64; LAS float* li_l = wsl; LAS float* al_l = wsl + 32;
    LAS float* tabL = (LAS float*)(lds + L_TAB);
    __syncthreads();
    if (tid < BTAB_N) tabL[tid] = btab[h * BTAB_N + tid];
    __syncthreads();
    const float cL = tabL[0], cR = tabL[BTAB_N - 1];
    unsigned koff, voffA, voffB;
    { const int row = wid * 8 + (lane >> 3), c16 = (lane & 7) ^ ((row >> 1) & 7); koff = (unsigned)((row * LD + c16 * 8) * 2);
      const int within = lane & 31;
#pragma unroll
      for (int i = 0; i < 2; ++i) { const int sub = (2 * wid + i) * 2 + (lane >> 5); const int kk = (sub >> 2) * 8 + (within >> 2);
          const int k = (kk & ~0xC) | ((kk & 4) << 1) | ((kk & 8) >> 1), c = (sub & 3) * 32 + (within & 3) * 8;
          const unsigned o = (unsigned)((k * LD + c) * 2); if (i == 0) voffA = o; else voffB = o; } }
    const int vb0 = (int)(unsigned)(uintptr_t)V_lds + v_rd_base(lane);
    const bf16_t* Vh = proj + rowbase * LD + OV + h * 128;
#pragma unroll 1
    for (int s = 0; s < 2; ++s) {
        const int hq = 2 * h + s;
        const bf16_t* Kh = proj + rowbase * LD + OKK + hq * 64;
        const bf16_t* Qw = proj + (rowbase + qw + r32) * LD + OQ + hq * 64 + hi * 8;
        float m_reg = -1e30f, l_reg = 0; f32x16 o[4]; bf16x8 qr[4];
#pragma unroll
        for (int d0 = 0; d0 < 4; ++d0) { o[d0] = f32x16{}; qr[d0] = *(const bf16x8*)(Qw + d0 * 16); }
#define DMA_TILE(t, buf) do { const char* vt_ = (const char*)Vh + (size_t)(t) * (64 * LD * 2); const char* kt_ = (const char*)Kh + (size_t)(t) * (64 * LD * 2); \
        __builtin_amdgcn_global_load_lds((const unsigned*)(kt_ + koff), (LAS unsigned*)(K_lds + (buf) * SHM_K + wid * 1024), 16, 0, 0); \
        __builtin_amdgcn_global_load_lds((const unsigned*)(vt_ + voffA), (LAS unsigned*)(V_lds + (buf) * SHM_V + (2 * wid) * 1024), 16, 0, 0); \
        __builtin_amdgcn_global_load_lds((const unsigned*)(vt_ + voffB), (LAS unsigned*)(V_lds + (buf) * SHM_V + (2 * wid + 1) * 1024), 16, 0, 0); } while (0)
#define WAITBAR(N) asm volatile("s_waitcnt vmcnt(" #N ") lgkmcnt(0)\n\ts_barrier" ::: "memory")
#define RESC(a) do { if (__any((a) < 1.f)) { if (hi == 0) al_l[r32] = (a); asm volatile("s_waitcnt lgkmcnt(0)" ::: "memory"); \
        _Pragma("unroll") for (int d = 0; d < 4; ++d) _Pragma("unroll") for (int r = 0; r < 16; ++r) o[d][r] *= al_l[crow(r, hi)]; } } while (0)
        f32x16 pA0, pA1, pB0, pB1; float mnA, mnB, alA, alB, bo; bf16x8 pa0, pa1, pa2, pa3; constexpr int NT = T / 64;
        asm volatile("s_waitcnt vmcnt(0) lgkmcnt(0)" ::: "memory"); __syncthreads();
        DMA_TILE(0, 0); DMA_TILE(1, 1);
        WAITBAR(3);
        bo = qkt(pA0, pA1, K_lds, qr, r32, hi, 0 - qw, cL, cR, tabL); partialSM(pA0, pA1, m_reg, mnA, alA, bo);
        int bc = 1, bp = 0, bn = 2;
#define ROT() do { const int t_ = bp; bp = bc; bc = bn; bn = t_; } while (0)
#pragma unroll 1
        for (int j = 1; j + 1 < NT; j += 2) {
            WAITBAR(0);
            DMA_TILE(j + 1, bn);
            SBAR(); bo = qkt(pB0, pB1, K_lds + bc * SHM_K, qr, r32, hi, j * 64 - qw, cL, cR, tabL);
            finishSM(pA0, pA1, alA, l_reg, pa0, pa1, pa2, pa3); SBAR();
            pv_d0(o, vb0 + bp * SHM_V, pa0, pa1, pa2, pa3); partialSM(pB0, pB1, m_reg, mnB, alB, bo);
            RESC(alB); ROT();
            WAITBAR(0);
            if (j + 2 < NT) DMA_TILE(j + 2, bn);
            SBAR(); bo = qkt(pA0, pA1, K_lds + bc * SHM_K, qr, r32, hi, (j + 1) * 64 - qw, cL, cR, tabL);
            finishSM(pB0, pB1, alB, l_reg, pa0, pa1, pa2, pa3); SBAR();
            pv_d0(o, vb0 + bp * SHM_V, pa0, pa1, pa2, pa3); partialSM(pA0, pA1, m_reg, mnA, alA, bo);
            RESC(alA); ROT();
        }
        WAITBAR(0);
        SBAR(); bo = qkt(pB0, pB1, K_lds + bc * SHM_K, qr, r32, hi, (NT - 1) * 64 - qw, cL, cR, tabL);
        finishSM(pA0, pA1, alA, l_reg, pa0, pa1, pa2, pa3); SBAR();
        pv_d0(o, vb0 + bp * SHM_V, pa0, pa1, pa2, pa3); partialSM(pB0, pB1, m_reg, mnB, alB, bo);
        RESC(alB);
        finishSM(pB0, pB1, alB, l_reg, pa0, pa1, pa2, pa3); SBAR();
        pv_d0(o, vb0 + bc * SHM_V, pa0, pa1, pa2, pa3);
#undef ROT
#undef DMA_TILE
#undef WAITBAR
#undef RESC
        if (hi == 0) li_l[r32] = l_reg; asm volatile("s_waitcnt lgkmcnt(0)" ::: "memory");
        float rli[16];
#pragma unroll
        for (int r = 0; r < 16; ++r) rli[r] = __builtin_amdgcn_rcpf(li_l[crow(r, hi)]);
        int tl = tid; asm volatile("" : "+v"(tl));
        f32x4* o1p = (f32x4*)(o1scr + (size_t)tl * 64);
        if (s == 0) {
#pragma unroll
            for (int d0 = 0; d0 < 4; ++d0)
#pragma unroll
                for (int r4 = 0; r4 < 4; ++r4)
                    o1p[d0 * 4 + r4] = (f32x4){o[d0][4 * r4] * rli[4 * r4], o[d0][4 * r4 + 1] * rli[4 * r4 + 1], o[d0][4 * r4 + 2] * rli[4 * r4 + 2], o[d0][4 * r4 + 3] * rli[4 * r4 + 3]};
        } else {
#pragma unroll
            for (int d0 = 0; d0 < 4; ++d0)
#pragma unroll
                for (int r4 = 0; r4 < 4; ++r4) { const f32x4 p = o1p[d0 * 4 + r4];
#pragma unroll
                    for (int e = 0; e < 4; ++e) o[d0][4 * r4 + e] = p[e] - lam * (o[d0][4 * r4 + e] * rli[4 * r4 + e]); }
            float ssq[16];
#pragma unroll
            for (int r = 0; r < 16; ++r) { float a2 = 0.f;
#pragma unroll
                for (int d0 = 0; d0 < 4; ++d0) a2 += o[d0][r] * o[d0][r];
                a2 += __shfl_xor(a2, 1); a2 += __shfl_xor(a2, 2); a2 += __shfl_xor(a2, 4); a2 += __shfl_xor(a2, 8); a2 += __shfl_xor(a2, 16);
                ssq[r] = __builtin_amdgcn_rsqf(a2 * (1.0f / 128.0f) + EPS) * outscale; }
            const int r32l = tl & 31, hil = (tl >> 5) & 1;
            float gn[4];
#pragma unroll
            for (int d0 = 0; d0 < 4; ++d0) gn[d0] = gain[h * 128 + d0 * 32 + r32l];
            bf16_t* Ow = merged + (rowbase + qw + 4 * hil) * D + h * 128 + r32l;
#pragma unroll
            for (int r = 0; r < 16; ++r) { bf16_t* orp = Ow + (long)((r & 3) + 8 * (r >> 2)) * D;
#pragma unroll
                for (int d0 = 0; d0 < 4; ++d0) orp[d0 * 32] = (bf16_t)f2bf(o[d0][r] * ssq[r] * gn[d0]); }
        }
    }
}
#undef SBAR
}

namespace lin {
constexpr int LD = INP, PT = 72;
constexpr int L_CUM = 0, L_VT = 32768, L_QK = L_VT + 128 * PT * 2, L_P = L_QK + 4 * 64 * PT * 2, L_OL = L_QK, OLP = 132;
__device__ __forceinline__ int crow(int r, int hi) { return (r & 3) + 8 * (r >> 2) + 4 * hi; }
__device__ __forceinline__ int seqidx(int b, int hl, int dir, int c) { return ((b * 8 + hl) * 2 + dir) * 64 + c; }

__device__ __forceinline__ void build_cum(const Args& a, int L, int hl, long R0, const bf16_t* __restrict__ proj, LAS unsigned char* lds) {
    const int tid = otid(); LAS float* cum = (LAS float*)(lds + L_CUM);
    const int k = tid & 63, dir = (tid >> 6) & 1, isub = tid >> 7;
    if (hl < 4) {
        float gw[16];
#pragma unroll
        for (int r = 0; r < 16; ++r) gw[r] = a.gate_w[((size_t)(L * 2 + dir) * 16 + r) * 256 + hl * 64 + k];
        const float gb = a.gate_b[(L * 2 + dir) * 256 + hl * 64 + k];
#pragma unroll 4
        for (int it = 0; it < 16; ++it) { const int i = isub + 4 * it; const bf16_t* ga = proj + (R0 + i) * LD + GAF + dir * 16;
            const u32x4 g0 = *(const u32x4*)ga, g1 = *(const u32x4*)(ga + 8);
            float x = gb;
            x += gw[0] * bflo(g0.x) + gw[1] * bfhi(g0.x) + gw[2] * bflo(g0.y) + gw[3] * bfhi(g0.y) + gw[4] * bflo(g0.z) + gw[5] * bfhi(g0.z) + gw[6] * bflo(g0.w) + gw[7] * bfhi(g0.w);
            x += gw[8] * bflo(g1.x) + gw[9] * bfhi(g1.x) + gw[10] * bflo(g1.y) + gw[11] * bfhi(g1.y) + gw[12] * bflo(g1.z) + gw[13] * bfhi(g1.z) + gw[14] * bflo(g1.w) + gw[15] * bfhi(g1.w);
            cum[(dir * 64 + i) * 64 + k] = logsigmoidf(x) * (1.0f / 16.0f); }
    } else {
        const float lg = logsigmoidf(a.decay_logit[(L * 2 + dir) * 4 + (hl - 4)]);
#pragma unroll 4
        for (int it = 0; it < 16; ++it) cum[(dir * 64 + isub + 4 * it) * 64 + k] = lg;
    }
    __syncthreads();
    if (tid < 128) { const int d = tid >> 6; float run = 0.f;
        if (d == 0) {
#pragma unroll 8
            for (int i = 0; i < 64; ++i) { run += cum[i * 64 + k]; cum[i * 64 + k] = run; }
        } else {
#pragma unroll 8
            for (int i = 63; i >= 0; --i) { run += cum[(64 + i) * 64 + k]; cum[(64 + i) * 64 + k] = run; }
        } }
    __syncthreads();
}
__device__ __forceinline__ void load_qk16(const Args& a, const bf16_t* __restrict__ src, int hl, int pos, int g, float (&va)[8], float (&vb)[8]) {
    const u32x4 wa = *(const u32x4*)(src + g * 8), wb = *(const u32x4*)(src + 32 + g * 8);
    va[0] = bflo(wa.x); va[1] = bfhi(wa.x); va[2] = bflo(wa.y); va[3] = bfhi(wa.y); va[4] = bflo(wa.z); va[5] = bfhi(wa.z); va[6] = bflo(wa.w); va[7] = bfhi(wa.w);
    vb[0] = bflo(wb.x); vb[1] = bfhi(wb.x); vb[2] = bflo(wb.y); vb[3] = bfhi(wb.y); vb[4] = bflo(wb.z); vb[5] = bfhi(wb.z); vb[6] = bflo(wb.w); vb[7] = bfhi(wb.w);
    if (hl >= 4) { const f32x2* rp = (const f32x2*)(a.ws + WS_ROPE) + pos * 32 + g * 8;
#pragma unroll
        for (int e = 0; e < 8; ++e) { const f32x2 cs = rp[e]; const float x1 = va[e], x2 = vb[e]; va[e] = x1 * cs.x - x2 * cs.y; vb[e] = x1 * cs.y + x2 * cs.x; } }
}
__device__ __forceinline__ u32x4 pack8(const float (&v)[8]) { u32x4 w; w.x = cvt_pk_bf16(v[0], v[1]); w.y = cvt_pk_bf16(v[2], v[3]); w.z = cvt_pk_bf16(v[4], v[5]); w.w = cvt_pk_bf16(v[6], v[7]); return w; }

__device__ __forceinline__ void r1_item(const Args& a, int L, int item, LAS unsigned char* lds) {
    const int tid = otid(), wid = tid >> 6, lane = tid & 63, r32 = lane & 31, hi = lane >> 5;
    const int b = item >> 9, hl = (item >> 6) & 7, c = item & 63; const long R0 = (long)b * T + c * 64;
    const bf16_t* proj = (const bf16_t*)(a.ws + WS_PROJ);
    __syncthreads();
    build_cum(a, L, hl, R0, proj, lds);
    LAS float* cum = (LAS float*)(lds + L_CUM);
    LAS bf16_t* VT = (LAS bf16_t*)(lds + L_VT); LAS bf16_t* KeT = (LAS bf16_t*)(lds + L_QK);
    if (tid < 256) { const int i = (tid >> 2) & 63, g = tid & 3; const int kcol = hl < 4 ? GK + hl * 64 : RK + (hl - 4) * 64;
        float va[8], vb[8]; load_qk16(a, proj + (R0 + i) * LD + kcol, hl, c * 64 + i, g, va, vb);
#pragma unroll
        for (int dir = 0; dir < 2; ++dir) { const int lastrow = dir == 0 ? 63 : 64;
#pragma unroll
            for (int e = 0; e < 8; ++e) { const int ka = g * 8 + e, kb = 32 + g * 8 + e;
                const float wa = __expf(cum[lastrow * 64 + ka] - cum[(dir * 64 + i) * 64 + ka]), wb = __expf(cum[lastrow * 64 + kb] - cum[(dir * 64 + i) * 64 + kb]);
                KeT[(dir * 64 + ka) * PT + i] = (bf16_t)f2bf(va[e] * wa); KeT[(dir * 64 + kb) * PT + i] = (bf16_t)f2bf(vb[e] * wb); } }
    } else { const int t2 = tid - 256, j = t2 >> 2, vg = t2 & 3; const int vcol = hl < 4 ? GV + hl * 128 : RV + (hl - 4) * 128;
        const bf16_t* vp = proj + (R0 + j) * LD + vcol + vg * 32;
#pragma unroll
        for (int q = 0; q < 4; ++q) { const u32x4 w = *(const u32x4*)(vp + q * 8); const int v0 = vg * 32 + q * 8;
            VT[(v0 + 0) * PT + j] = (bf16_t)(w.x & 0xffff); VT[(v0 + 1) * PT + j] = (bf16_t)(w.x >> 16); VT[(v0 + 2) * PT + j] = (bf16_t)(w.y & 0xffff); VT[(v0 + 3) * PT + j] = (bf16_t)(w.y >> 16);
            VT[(v0 + 4) * PT + j] = (bf16_t)(w.z & 0xffff); VT[(v0 + 5) * PT + j] = (bf16_t)(w.z >> 16); VT[(v0 + 6) * PT + j] = (bf16_t)(w.w & 0xffff); VT[(v0 + 7) * PT + j] = (bf16_t)(w.w >> 16); } }
    __syncthreads();
    { const int dir = wid >> 2, mt = wid & 3; f32x16 acc0 = f32x16{}, acc1 = f32x16{};
#pragma unroll
        for (int ks = 0; ks < 4; ++ks) { const bf16x8 av = *(const LAS bf16x8*)(VT + (mt * 32 + r32) * PT + ks * 16 + hi * 8);
            const bf16x8 b0 = *(const LAS bf16x8*)(KeT + (dir * 64 + r32) * PT + ks * 16 + hi * 8), b1 = *(const LAS bf16x8*)(KeT + (dir * 64 + 32 + r32) * PT + ks * 16 + hi * 8);
            acc0 = __builtin_amdgcn_mfma_f32_32x32x16_bf16(av, b0, acc0, 0, 0, 0); acc1 = __builtin_amdgcn_mfma_f32_32x32x16_bf16(av, b1, acc1, 0, 0, 0); }
        bf16_t* kvt = (bf16_t*)(a.ws + WS_KVT) + (size_t)seqidx(b, hl, dir, c) * 8192;
#pragma unroll
        for (int r = 0; r < 16; ++r) { const int v = mt * 32 + crow(r, hi); kvt[v * 64 + r32] = (bf16_t)f2bf(acc0[r]); kvt[v * 64 + 32 + r32] = (bf16_t)f2bf(acc1[r]); } }
    if (tid < 128) { const int dir = tid >> 6, k = tid & 63; ((float*)(a.ws + WS_DEC))[(size_t)seqidx(b, hl, dir, c) * 64 + k] = __expf(cum[(dir == 0 ? 63 : 64) * 64 + k]); }
}

__device__ __forceinline__ void scan_phase(const Args& a) {
    const bf16_t* kvt = (const bf16_t*)(a.ws + WS_KVT); const float* dec = (const float*)(a.ws + WS_DEC); bf16_t* st = (bf16_t*)(a.ws + WS_ST);
    const int tid = otid();
    for (int g = blockIdx.x * NTHR + tid; g < 32 * 4096; g += gridDim.x * NTHR) {
        const int seq = g >> 12, e2 = g & 4095, v = e2 >> 5, k2 = (e2 & 31) * 2, dir = seq & 1; float s0 = 0.f, s1 = 0.f;
#pragma unroll 8
        for (int step = 0; step < 64; ++step) { const int c = dir ? 63 - step : step; const size_t idx = (size_t)seq * 64 + c;
            const unsigned kw = *(const unsigned*)(kvt + idx * 8192 + v * 64 + k2); const f32x2 kv = (f32x2){bflo(kw), bfhi(kw)}; const f32x2 d = *(const f32x2*)(dec + idx * 64 + k2);
            *(unsigned*)(st + idx * 8192 + v * 64 + k2) = cvt_pk_bf16(s0, s1);
            s0 = d.x * s0 + kv.x; s1 = d.y * s1 + kv.y; }
    }
}

__device__ __forceinline__ void r3_item(const Args& a, int L, int item, LAS unsigned char* lds) {
    const int tid = otid(), wid = tid >> 6, lane = tid & 63, r32 = lane & 31, hi = lane >> 5;
    const int b = item >> 9, hl = (item >> 6) & 7, c = item & 63; const long R0 = (long)b * T + c * 64;
    const bf16_t* proj = (const bf16_t*)(a.ws + WS_PROJ);
    __syncthreads();
    build_cum(a, L, hl, R0, proj, lds);
    LAS float* cum = (LAS float*)(lds + L_CUM);
    LAS bf16_t* VT = (LAS bf16_t*)(lds + L_VT); LAS bf16_t* QK = (LAS bf16_t*)(lds + L_QK);
    LAS bf16_t* P = (LAS bf16_t*)(lds + L_P);
    { const int mat = tid >> 8, i = (tid >> 2) & 63, g = tid & 3;
        const int col = mat == 0 ? (hl < 4 ? GQ + hl * 64 : RQ + (hl - 4) * 64) : (hl < 4 ? GK + hl * 64 : RK + (hl - 4) * 64);
        float va[8], vb[8]; load_qk16(a, proj + (R0 + i) * LD + col, hl, c * 64 + i, g, va, vb);
        const float sg = mat == 0 ? 1.f : -1.f;
#pragma unroll
        for (int dir = 0; dir < 2; ++dir) { float ta[8], tb[8];
#pragma unroll
            for (int e = 0; e < 8; ++e) { ta[e] = va[e] * __expf(sg * cum[(dir * 64 + i) * 64 + g * 8 + e]); tb[e] = vb[e] * __expf(sg * cum[(dir * 64 + i) * 64 + 32 + g * 8 + e]); }
            LAS bf16_t* dst = QK + ((dir * 2 + mat) * 64 + i) * PT;
            *(LAS u32x4*)(dst + g * 8) = pack8(ta); *(LAS u32x4*)(dst + 32 + g * 8) = pack8(tb); } }
    { const int j = tid >> 3, vg = tid & 7; const int vcol = hl < 4 ? GV + hl * 128 : RV + (hl - 4) * 128;
        const bf16_t* vp = proj + (R0 + j) * LD + vcol + vg * 16;
#pragma unroll
        for (int q = 0; q < 2; ++q) { const u32x4 w = *(const u32x4*)(vp + q * 8); const int v0 = vg * 16 + q * 8;
            VT[(v0 + 0) * PT + j] = (bf16_t)(w.x & 0xffff); VT[(v0 + 1) * PT + j] = (bf16_t)(w.x >> 16); VT[(v0 + 2) * PT + j] = (bf16_t)(w.y & 0xffff); VT[(v0 + 3) * PT + j] = (bf16_t)(w.y >> 16);
            VT[(v0 + 4) * PT + j] = (bf16_t)(w.z & 0xffff); VT[(v0 + 5) * PT + j] = (bf16_t)(w.z >> 16); VT[(v0 + 6) * PT + j] = (bf16_t)(w.w & 0xffff); VT[(v0 + 7) * PT + j] = (bf16_t)(w.w >> 16); } }
    __syncthreads();
    { const int dir = wid >> 2, it = (wid >> 1) & 1, jt = wid & 1; f32x16 sc = f32x16{};
        const LAS bf16_t* Qt = QK + ((dir * 2 + 0) * 64) * PT; const LAS bf16_t* Kt = QK + ((dir * 2 + 1) * 64) * PT;
#pragma unroll
        for (int ks = 0; ks < 4; ++ks) { const bf16x8 av = *(const LAS bf16x8*)(Kt + (jt * 32 + r32) * PT + ks * 16 + hi * 8), bv = *(const LAS bf16x8*)(Qt + (it * 32 + r32) * PT + ks * 16 + hi * 8);
            sc = __builtin_amdgcn_mfma_f32_32x32x16_bf16(av, bv, sc, 0, 0, 0); }
        const int i = it * 32 + r32;
#pragma unroll
        for (int g4 = 0; g4 < 4; ++g4) { float v[4];
#pragma unroll
            for (int e = 0; e < 4; ++e) { const int j = jt * 32 + 8 * g4 + 4 * hi + e; const bool keep = dir == 0 ? (j <= i) : (j >= i); v[e] = keep ? sc[g4 * 4 + e] : 0.f; }
            u32x2 w; w.x = cvt_pk_bf16(v[0], v[1]); w.y = cvt_pk_bf16(v[2], v[3]);
            *(LAS u32x2*)(P + (dir * 64 + i) * PT + jt * 32 + 8 * g4 + 4 * hi) = w; } }
    __syncthreads();
    { const int it = wid >> 2, vt = wid & 3; f32x16 acc = f32x16{};
        bf16x8 stf[2][4];
#pragma unroll
        for (int dir = 0; dir < 2; ++dir) { const bf16_t* stp = (const bf16_t*)(a.ws + WS_ST) + (size_t)seqidx(b, hl, dir, c) * 8192 + (vt * 32 + r32) * 64 + hi * 8;
#pragma unroll
            for (int ks = 0; ks < 4; ++ks) stf[dir][ks] = *(const bf16x8*)(stp + ks * 16); }
#pragma unroll
        for (int dir = 0; dir < 2; ++dir) { const LAS bf16_t* Qt = QK + ((dir * 2 + 0) * 64) * PT;
#pragma unroll
            for (int ks = 0; ks < 4; ++ks) { const bf16x8 av = *(const LAS bf16x8*)(P + (dir * 64 + it * 32 + r32) * PT + ks * 16 + hi * 8), bv = *(const LAS bf16x8*)(VT + (vt * 32 + r32) * PT + ks * 16 + hi * 8);
                acc = __builtin_amdgcn_mfma_f32_32x32x16_bf16(av, bv, acc, 0, 0, 0); }
#pragma unroll
            for (int ks = 0; ks < 4; ++ks) { const bf16x8 av = *(const LAS bf16x8*)(Qt + (it * 32 + r32) * PT + ks * 16 + hi * 8), bv = stf[dir][ks];
                acc = __builtin_amdgcn_mfma_f32_32x32x16_bf16(av, bv, acc, 0, 0, 0); } }
        __syncthreads();
        LAS float* OL = (LAS float*)(lds + L_OL);
#pragma unroll
        for (int r = 0; r < 16; ++r) OL[(it * 32 + crow(r, hi)) * OLP + vt * 32 + r32] = acc[r]; }
    __syncthreads();
    { const int row = tid >> 3, seg = tid & 7; const LAS float* op = (const LAS float*)(lds + L_OL) + row * OLP + seg * 16; float ov[16]; float s = 0.f;
#pragma unroll
        for (int e = 0; e < 16; ++e) { ov[e] = op[e]; s += ov[e] * ov[e]; }
        s += __shfl_xor(s, 1); s += __shfl_xor(s, 2); s += __shfl_xor(s, 4);
        const float rs = rsqrtf(s * (1.0f / 128.0f) + EPS);
        const int gcol = (hl < 4 ? GR + hl * 128 : RG + (hl - 4) * 128) + seg * 16;
        const bf16_t* gp = proj + (R0 + row) * LD + gcol; const u32x4 g0 = *(const u32x4*)gp, g1 = *(const u32x4*)(gp + 8);
        float gt[16] = {bflo(g0.x), bfhi(g0.x), bflo(g0.y), bfhi(g0.y), bflo(g0.z), bfhi(g0.z), bflo(g0.w), bfhi(g0.w), bflo(g1.x), bfhi(g1.x), bflo(g1.y), bfhi(g1.y), bflo(g1.z), bfhi(g1.z), bflo(g1.w), bfhi(g1.w)};
        const float* hg = a.head_gain + (size_t)L * D + 1024 + hl * 128 + seg * 16;
        float res[16];
#pragma unroll
        for (int e = 0; e < 16; ++e) res[e] = ov[e] * rs * hg[e] * siluf(gt[e]);
        bf16_t* mp = (bf16_t*)(a.ws + WS_MRG) + (R0 + row) * D + 1024 + hl * 128 + seg * 16;
        u32x4 w0, w1; w0.x = cvt_pk_bf16(res[0], res[1]); w0.y = cvt_pk_bf16(res[2], res[3]); w0.z = cvt_pk_bf16(res[4], res[5]); w0.w = cvt_pk_bf16(res[6], res[7]);
        w1.x = cvt_pk_bf16(res[8], res[9]); w1.y = cvt_pk_bf16(res[10], res[11]); w1.z = cvt_pk_bf16(res[12], res[13]); w1.w = cvt_pk_bf16(res[14], res[15]);
        *(u32x4*)mp = w0; *(u32x4*)(mp + 8) = w1; }
}
}

__device__ __forceinline__ void unpack8(const u32x4 w, float (&v)[8]) { v[0] = bflo(w.x); v[1] = bfhi(w.x); v[2] = bflo(w.y); v[3] = bfhi(w.y); v[4] = bflo(w.z); v[5] = bfhi(w.z); v[6] = bflo(w.w); v[7] = bfhi(w.w); }
__device__ __forceinline__ void conv_phase(const Args& a, int L) {
    const float* HB = (const float*)(a.ws + WS_U); bf16_t* act = (bf16_t*)(a.ws + WS_ACT);
    const float* cw = a.conv_w + (size_t)L * 3 * UPW;
    const int tid = otid(); constexpr int NTN = UPW / 256, NTILE = (M / 256) * NTN;
    for (int idx = blockIdx.x * NTHR + tid; idx < NTILE * 256; idx += gridDim.x * NTHR) {
        const int tile = idx >> 8, side = (idx >> 7) & 1, lc = idx & 127, pm = tile / NTN, pn = tile % NTN, ch = pn * 128 + lc;
        const float* hb = HB + (size_t)tile * 1024;
        float pa = hb[(2 + side) * 256 + lc], pg = hb[(2 + side) * 256 + 128 + lc];
        if (side == 0 && (pm & 15) != 0) { const float* nb = HB + (size_t)(tile - NTN) * 1024 + 256; pa += cw[ch] * nb[lc]; pg += cw[DFF + ch] * nb[128 + lc]; }
        if (side == 1 && (pm & 15) != 15) { const float* nb = HB + (size_t)(tile + NTN) * 1024; pa += cw[2 * UPW + ch] * nb[lc]; pg += cw[2 * UPW + DFF + ch] * nb[128 + lc]; }
        act[(size_t)(pm * 256 + (side ? 255 : 0)) * DFF + ch] = (bf16_t)f2bf(pa * siluf(pg));
    }
}

__device__ __forceinline__ void final_phase(const Args& a) {
    const int tid = otid(); const int lane = tid & 63, gw = blockIdx.x * NWAVE + (tid >> 6), NGW = gridDim.x * NWAVE;
    const u64_t* ss = (const u64_t*)(a.ws + WS_SS) + 8 * M;
    for (int m = gw; m < M; m += NGW) { const float rs = ss_rstd(ss, m); f32x4* xr = (f32x4*)(a.out + (size_t)m * D) + lane; const f32x4* gp = (const f32x4*)a.final_g + lane;
#pragma unroll
        for (int j = 0; j < 8; ++j) { const f32x4 v = xr[64 * j]; xr[64 * j] = v * rs * gp[64 * j]; } }
}


__device__ __forceinline__ void inproj_strip(const bf16_t* __restrict__ xb, const bf16_t* __restrict__ wt, const u64_t* ss, bf16_t* proj, int G, int bx, LAS unsigned char* lds) {
    const int tid = otid(), wid = tid >> 6, lane = tid & 63, r32 = lane & 31, hi = lane >> 5;
    LAS float* red = (LAS float*)lds;
    for (int rb = bx; rb < M / 32; rb += G) {
        const bf16_t* ap = xb + (size_t)(rb * 32 + r32) * D + wid * 256 + hi * 8;
        const bf16_t* bp = wt + (size_t)(GAF + r32) * D + wid * 256 + hi * 8;
        f32x16 acc = f32x16{};
#pragma unroll
        for (int ks = 0; ks < 16; ++ks) { const bf16x8 av = *(const bf16x8*)(ap + ks * 16), bv = *(const bf16x8*)(bp + ks * 16);
            acc = __builtin_amdgcn_mfma_f32_32x32x16_bf16(av, bv, acc, 0, 0, 0); }
        __syncthreads();
#pragma unroll
        for (int r = 0; r < 16; ++r) red[(wid * 32 + ((r & 3) + 8 * (r >> 2) + 4 * hi)) * 33 + r32] = acc[r];
        __syncthreads();
        for (int o = tid; o < 1024; o += NTHR) { const int row = o >> 5, col = o & 31; float v = 0.f;
#pragma unroll
            for (int w = 0; w < 8; ++w) v += red[(w * 32 + row) * 33 + col];
            proj[(size_t)(rb * 32 + row) * INP + GAF + col] = (bf16_t)f2bf(v * ss_rstd(ss, rb * 32 + row)); }
    }
    __syncthreads();
}

#define XB_TMO      128
#define XB_XCNT(j)  (256  + 64 * (j))
#define XB_XSUB(j)  (1280 + 64 * (j))
#define XB_XGEN(j)  (2304 + 64 * (j))
#define XB_TOP      3328
#define XB_TOPGEN   3392
#define XCD_BAR_WORDS 3456
#define XB_SPIN_CAP (1u << 18)
__device__ __forceinline__ unsigned xb_ld(unsigned* p)              { return __hip_atomic_load(p, __ATOMIC_RELAXED, __HIP_MEMORY_SCOPE_AGENT); }
__device__ __forceinline__ unsigned xb_add(unsigned* p, unsigned v) { return __hip_atomic_fetch_add(p, v, __ATOMIC_RELAXED, __HIP_MEMORY_SCOPE_AGENT); }
__device__ __forceinline__ unsigned xb_xcc_id() { return (unsigned)__builtin_amdgcn_s_getreg((3 << 11) | 20) & 0xFu; }
#define XB_SPIN(cond, bar) do { unsigned _sp = 0; while (cond) { __builtin_amdgcn_s_sleep(1); \
    if ((++_sp & 255u) == 0u) { if (xb_ld(&(bar)[XB_TMO])) break; if (_sp > XB_SPIN_CAP) { atomicAdd(&(bar)[XB_TMO], 1u); break; } } } } while (0)
struct XcdBarrier { unsigned* bar; unsigned x; volatile LAS unsigned* st; };
__device__ __forceinline__ XcdBarrier xcd_barrier_post(unsigned* bar, volatile LAS unsigned* st) {
    XcdBarrier b; b.bar = bar; b.x = xb_xcc_id(); b.st = st;
    if (threadIdx.x == 0) (void)xb_add(&bar[XB_XCNT(b.x)], 1u);
    return b;
}
__device__ __forceinline__ void xcd_barrier_complete(unsigned* bar, unsigned x, unsigned& nloc, unsigned& nx) {
    const unsigned G = gridDim.x * gridDim.y * gridDim.z;
    unsigned sum, cnt, mine, sp = 0u;
    for (;;) {
        sum = 0u; cnt = 0u; mine = 0u;
#pragma unroll
        for (unsigned j = 0; j < 16; ++j) { const unsigned c = xb_ld(&bar[XB_XCNT(j)]); sum += c; cnt += (c > 0u) ? 1u : 0u; mine = (j == x) ? c : mine; }
        if (sum == G) break;
        __builtin_amdgcn_s_sleep(1);
        if ((++sp & 255u) == 0u) { if (xb_ld(&bar[XB_TMO])) break; if (sp > XB_SPIN_CAP) { atomicAdd(&bar[XB_TMO], 1u); break; } }
    }
    nloc = mine > 0u ? mine : 1u; nx = cnt > 0u ? cnt : 1u;
}
__device__ __forceinline__ void xcd_barrier(const XcdBarrier& b) {
    asm volatile("s_waitcnt vmcnt(0)" ::: "memory");
    __syncthreads();
    if (threadIdx.x == 0) {
        unsigned* bar = b.bar;
        __builtin_amdgcn_s_waitcnt(0);
        unsigned nloc = b.st[0], nx = b.st[1];
        if (nloc == 0u) { xcd_barrier_complete(bar, b.x, nloc, nx); b.st[0] = nloc; b.st[1] = nx; }
        const unsigned old = xb_add(&bar[XB_XSUB(b.x)], 1u);
        const unsigned gen = old / nloc;
        if (old + 1u == (gen + 1u) * nloc) {
            __builtin_amdgcn_fence(__ATOMIC_RELEASE, "agent");
            asm volatile("s_waitcnt vmcnt(0)" ::: "memory");
            const unsigned og = xb_add(&bar[XB_TOP], 1u);
            const unsigned tg = og / nx;
            if (og + 1u == (tg + 1u) * nx) xb_add(&bar[XB_TOPGEN], 1u);
            else XB_SPIN(xb_ld(&bar[XB_TOPGEN]) == tg, bar);
            __builtin_amdgcn_fence(__ATOMIC_ACQUIRE, "agent");
            xb_add(&bar[XB_XGEN(b.x)], 1u);
            asm volatile("s_waitcnt vmcnt(0)" ::: "memory");
        } else {
            XB_SPIN(xb_ld(&bar[XB_XGEN(b.x)]) == gen, bar);
            __builtin_amdgcn_fence(__ATOMIC_ACQUIRE, "agent");
            asm volatile("s_waitcnt vmcnt(0)" ::: "memory");
        }
    }
    __syncthreads();
}

constexpr int N_PHASES = 2 + 8 * DEPTH;
#ifndef GEMM_ALIGN
#define GEMM_ALIGN true
#endif
#ifndef WGM_IN
#define WGM_IN 4
#endif
#ifndef WGM_UP
#define WGM_UP 2
#endif
#ifndef WGM_RES
#define WGM_RES 4
#endif
__global__ void __launch_bounds__(NTHR, 2) mega_fwd(Args a0) {
    extern __shared__ __attribute__((aligned(16))) unsigned char lds_raw[];
    LAS unsigned char* lds = (LAS unsigned char*)lds_raw;
    volatile LAS unsigned* MISC = (volatile LAS unsigned*)(lds + 131072);
    if (threadIdx.x < 32) MISC[threadIdx.x] = 0u;
    if (threadIdx.x < 256) ((LAS float*)(lds + 131072 + 256))[8 * 256 + threadIdx.x] = 0.f;
    __syncthreads();
    XcdBarrier gbar; gbar.bar = (unsigned*)(a0.ws + WS_BAR); gbar.x = 0; gbar.st = MISC + 8;
    if (a0.ph_hi - a0.ph_lo > 1) gbar = xcd_barrier_post((unsigned*)(a0.ws + WS_BAR), MISC + 8);
    bool first_sync = true;
#define GRID_SYNC() do { if (first_sync) { cg::this_grid().sync(); first_sync = false; } else xcd_barrier(gbar); } while (0)
    for (int ph = a0.ph_lo; ph < a0.ph_hi; ++ph) {
      int G = gridDim.x, bx = blockIdx.x; asm volatile("" : "+s"(G), "+s"(bx));
      const int vcu = (G % 8 == 0) ? (bx % 8) * (G / 8) + bx / 8 : bx;
      Args a = a0; asm volatile("" : "+s"(a.ws), "+s"(a.out), "+s"(a.x), "+s"(a.ln1_g), "+s"(a.w_in), "+s"(a.diff_lambda), "+s"(a.rel_bias), "+s"(a.gate_w), "+s"(a.gate_b), "+s"(a.decay_logit), "+s"(a.head_gain), "+s"(a.w_o), "+s"(a.ln2_g), "+s"(a.w_up), "+s"(a.conv_w), "+s"(a.conv_b), "+s"(a.w_down), "+s"(a.final_g));
      u64_t* ssb = (u64_t*)(a.ws + WS_SS);
      bf16_t* xb = (bf16_t*)(a.ws + WS_XB); bf16_t* proj = (bf16_t*)(a.ws + WS_PROJ); bf16_t* mrg = (bf16_t*)(a.ws + WS_MRG); bf16_t* actb = (bf16_t*)(a.ws + WS_ACT);
      const int sub_ = (ph == 0) ? 100 : (ph == N_PHASES - 1 ? 101 : ((ph - 1) & 7));
      const int nrep = (PROBE_SUB >= 0 && (sub_ == PROBE_SUB || (sub_ == 1 && (PROBE_SUB == 11 || PROBE_SUB == 12)))) ? 2 : 1;
      for (int rep = 0; rep < nrep; ++rep) {
        if (rep) GRID_SYNC();
        if (ph == 0) {
#ifndef NO_PRO
 phase_prologue(a, lds);
#endif
 }
        else if (ph == N_PHASES - 1) { final_phase(a); }
        else {
            const int L = (ph - 1) >> 3, sub = (ph - 1) & 7;
            const unsigned char* wl = a.ws + WS_W + (size_t)L * W_LAYER;
            if (sub == 0) {
                inproj_strip(xb, (const bf16_t*)(wl + W_IN), ssb + (2 * L) * M, proj, G, bx, lds);
                pg8::Gemm g{xb, (const bf16_t*)(wl + W_IN), M, NGEMM_IN, D}; pg8::StaticOrder S; S.init(M, NGEMM_IN, G, bx, WGM_IN);
                pg8::EpiScaleBf16 E{proj, INP, ssb + (2 * L) * M};
#if !defined(NO_GEMM) && !defined(NO_GEMM_A)
                pg8::gemm_phase<pg8::EpiScaleBf16, pg8::StaticOrder, GEMM_ALIGN, true>(lds, g, S, E);
#endif
            } else if (sub == 5) {
                pg8::Gemm g{xb, (const bf16_t*)(wl + W_UP), M, UPW, D}; pg8::StaticOrder S; S.init(M, UPW, G, bx, WGM_UP);
                pg8::EpiConvGate E{actb, ssb + (2 * L + 1) * M, a.conv_w + (size_t)L * 3 * UPW, a.conv_b + (size_t)L * UPW, (float*)(a.ws + WS_U), (LAS float*)(lds + 131072 + 256)};
#if !defined(NO_GEMM) && !defined(NO_GEMM_C)
                pg8::gemm_phase<pg8::EpiConvGate, pg8::StaticOrder, true, true>(lds, g, S, E);
#endif
            } else if (sub == 4 || sub == 7) {
                const bool dn = sub == 7;
                pg8::Gemm g{dn ? actb : mrg, (const bf16_t*)(wl + (dn ? W_DN : W_O)), M, D, dn ? DFF : D}; pg8::StaticOrder S; S.init(M, D, G, bx, WGM_RES);
                pg8::EpiResid E{a.out, xb, ssb + (2 * L + (dn ? 2 : 1)) * M};
#if !defined(NO_GEMM) && !defined(NO_GEMM_B)
                pg8::gemm_phase<pg8::EpiResid, pg8::StaticOrder, GEMM_ALIGN, true>(lds, g, S, E);
#endif
            } else if (sub == 1) {
#ifndef NO_R1
                if (!(rep && PROBE_SUB == 12)) for (int it = vcu; it < 1024; it += G) lin::r1_item(a, L, it, lds);
#endif
#ifndef NO_ATT
                const float lam = ((const float*)(a.ws + WS_LAM))[L]; const float li = 0.8f - 0.6f * __expf(-0.3f * (float)L);
                if (!(rep && PROBE_SUB == 11)) for (int u = vcu; u < 256; u += G)
                    att::attn_unit(u >> 7, (u >> 4) & 7, u & 15, proj, (const float*)(a.ws + WS_BTAB), lam, 1.0f - li, a.head_gain + (size_t)L * D,
                                   (float*)(a.ws + WS_O1) + (size_t)bx * 64 * NTHR, mrg, (LAS char*)lds);
#endif
            } else if (sub == 2) {
#ifndef NO_SCAN
                lin::scan_phase(a);
#endif
            } else if (sub == 3) {
#ifndef NO_R3
                for (int it = vcu; it < 1024; it += G) lin::r3_item(a, L, it, lds);
#endif
            } else {
#ifndef NO_CONV
                conv_phase(a, L);
#endif
            }
        }
      }
        if (ph + 1 < a0.ph_hi) GRID_SYNC();
    }
}

extern "C" void kernel_launch(void* const* d_in, const int* in_sizes, int n_in, void* d_out, int out_size, void* d_ws, size_t ws_size, hipStream_t stream) {
    static int grid = 0;
    if (grid == 0) {
        if (n_in != 16 || in_sizes[0] != M * D || out_size != M * D || ws_size < WS_END) {
            fprintf(stderr, "kernel_launch: unexpected shapes (n_in %d in0 %d out %d ws %zu need %zu)\n", n_in, n_in > 0 ? in_sizes[0] : -1, out_size, ws_size, (size_t)WS_END); grid = -1; return; }
        int dev = 0, cus = 0, per_cu = 0;
        hipGetDevice(&dev); hipDeviceGetAttribute(&cus, hipDeviceAttributeMultiprocessorCount, dev);
        if (hipFuncSetAttribute((const void*)mega_fwd, hipFuncAttributeMaxDynamicSharedMemorySize, LDS_BYTES) != hipSuccess) { fprintf(stderr, "kernel_launch: hipFuncSetAttribute failed\n"); grid = -1; return; }
        if (hipOccupancyMaxActiveBlocksPerMultiprocessor(&per_cu, (const void*)mega_fwd, NTHR, LDS_BYTES) != hipSuccess || per_cu < 1) { fprintf(stderr, "kernel_launch: occupancy query says %d\n", per_cu); per_cu = 1; }
        (void)hipGetLastError();
        grid = cus * 1;
        fprintf(stderr, "kernel_launch: grid %d (cus %d, per_cu %d)\n", grid, cus, per_cu);
    }
    if (grid < 0) return;
    hipMemsetAsync((char*)d_ws + WS_SS, 0, SS_BYTES, stream);
    Args a{};
    a.x = (const float*)d_in[0]; a.ln1_g = (const float*)d_in[1]; a.w_in = (const float*)d_in[2]; a.diff_lambda = (const float*)d_in[3]; a.rel_bias = (const float*)d_in[4];
    a.gate_w = (const float*)d_in[5]; a.gate_b = (const float*)d_in[6]; a.decay_logit = (const float*)d_in[7]; a.head_gain = (const float*)d_in[8]; a.w_o = (const float*)d_in[9];
    a.ln2_g = (const float*)d_in[10]; a.w_up = (const float*)d_in[11]; a.conv_w = (const float*)d_in[12]; a.conv_b = (const float*)d_in[13]; a.w_down = (const float*)d_in[14];
    a.final_g = (const float*)d_in[15]; a.out = (float*)d_out; a.ws = (unsigned char*)d_ws;
#if MK_MULTI
    for (int ph = 0; ph < N_PHASES; ++ph) { a.ph_lo = ph; a.ph_hi = ph + 1; hipLaunchKernelGGL(mega_fwd, dim3(grid), dim3(NTHR), LDS_BYTES, stream, a); }
#else
    a.ph_lo = 0; a.ph_hi = N_PHASES;
    void* args[] = {&a};
    hipError_t e = hipLaunchCooperativeKernel((const void*)mega_fwd, dim3(grid), dim3(NTHR), args, LDS_BYTES, stream);
    if (e != hipSuccess) fprintf(stderr, "kernel_launch: cooperative launch failed: %s (grid %d)\n", hipGetErrorString(e), grid);
#endif
}
```
